# Optimizing an MI355X kernel written in HIP

```python
import jax, jax.numpy as jnp
from jax import lax
import numpy as np

D_MODEL = 1024
BATCH = 2
SEQ = 16384
DEPTH = 2

CHUNK = 64
N_EVEN = (DEPTH + 1) // 2
N_ODD = DEPTH // 2
EPS = 1e-6

CONV_CH = D_MODEL // 2
CONV_W = 3
FOX_HEADS = 8
FOX_HEAD_DIM = 64
FOX_DIM = FOX_HEADS * FOX_HEAD_DIM
Q_BLOCK = 128
EVEN_IN = 3 * CONV_CH + 3 * FOX_DIM + FOX_HEADS
EVEN_SPLITS = (CONV_CH, 2 * CONV_CH, 3 * CONV_CH, 3 * CONV_CH + FOX_DIM,
               3 * CONV_CH + 2 * FOX_DIM, 3 * CONV_CH + 3 * FOX_DIM)

LRU_WIDTH = D_MODEL
LRU_HEADS = 8
LRU_BLOCK = LRU_WIDTH // LRU_HEADS
LRU_CONV_W = 4
LRU_C = 8.0

PEER_HEADS = 8
N_KEYS = 128
N_EXPERTS = N_KEYS * N_KEYS
PEER_TOPK = 16
QUERY_DIM = 256
HALF = QUERY_DIM // 2
TOKEN_BLOCK = 128

PLE_DIM = 256

kernel_name = "hybrid_conv_fox_rglru_peer_trunk"


def rms_norm(x, g):
    xf = x.astype(jnp.float32)
    y = xf * lax.rsqrt(jnp.mean(xf * xf, axis=-1, keepdims=True) + EPS)
    return (y * g.astype(jnp.float32)).astype(x.dtype)


def causal_conv(x, w):
    width = w.shape[0]
    s = x.shape[1]
    xp = jnp.pad(x, ((0, 0), (width - 1, 0), (0, 0)))
    y = xp[:, 0:s, :] * w[0]
    for k in range(1, width):
        y = y + xp[:, k:k + s, :] * w[k]
    return y


def forgetting_attention(q, k, v, log_f):
    b, s, h, dh = q.shape
    scale = dh ** -0.5
    fh = jnp.cumsum(log_f, axis=1).transpose(0, 2, 1)
    qh = q.transpose(0, 2, 1, 3)
    kh = k.transpose(0, 2, 1, 3)
    vh = v.transpose(0, 2, 1, 3)
    n_blk = s // Q_BLOCK

    def q_block(qi):
        start = qi * Q_BLOCK
        qb = lax.dynamic_slice_in_dim(qh, start, Q_BLOCK, axis=2).astype(jnp.float32)
        fq = lax.dynamic_slice_in_dim(fh, start, Q_BLOCK, axis=2)
        tq = start + jnp.arange(Q_BLOCK)

        def kv_step(kj, carry):
            m, l, acc = carry
            ks = kj * Q_BLOCK
            kb = lax.dynamic_slice_in_dim(kh, ks, Q_BLOCK, axis=2).astype(jnp.float32)
            vb = lax.dynamic_slice_in_dim(vh, ks, Q_BLOCK, axis=2).astype(jnp.float32)
            fk = lax.dynamic_slice_in_dim(fh, ks, Q_BLOCK, axis=2)
            tk = ks + jnp.arange(Q_BLOCK)
            sc = (jnp.einsum('bhqd,bhkd->bhqk', qb, kb) * scale
                  + fq[..., :, None] - fk[..., None, :])
            sc = jnp.where(tk[None, :] <= tq[:, None], sc, -jnp.inf)
            m_new = jnp.maximum(m, jnp.max(sc, axis=-1))
            pr = jnp.exp(sc - m_new[..., None])
            corr = jnp.exp(m - m_new)
            l = l * corr + jnp.sum(pr, axis=-1)
            acc = acc * corr[..., None] + jnp.einsum('bhqk,bhkd->bhqd', pr, vb)
            return m_new, l, acc

        init = (jnp.full((b, h, Q_BLOCK), -jnp.inf, jnp.float32),
                jnp.zeros((b, h, Q_BLOCK), jnp.float32),
                jnp.zeros((b, h, Q_BLOCK, dh), jnp.float32))
        _, l, acc = lax.fori_loop(0, qi + 1, kv_step, init)
        return acc / l[..., None]

    out = lax.map(q_block, jnp.arange(n_blk))
    out = out.transpose(1, 0, 3, 2, 4).reshape(b, s, h * dh)
    return out.astype(q.dtype)


def mix_even(hn, w_in, b_forget, conv_w, q_gain, k_gain, w_out):
    b, s, _ = hn.shape
    z = hn @ w_in
    gb, gc, xa, q, k, v, f = jnp.split(z, EVEN_SPLITS, axis=-1)
    ya = gb * causal_conv(gc * xa, conv_w)
    q = rms_norm(q.reshape(b, s, FOX_HEADS, FOX_HEAD_DIM), q_gain)
    k = rms_norm(k.reshape(b, s, FOX_HEADS, FOX_HEAD_DIM), k_gain)
    v = v.reshape(b, s, FOX_HEADS, FOX_HEAD_DIM)
    log_f = jax.nn.log_sigmoid(f.astype(jnp.float32) + b_forget.astype(jnp.float32))
    yb = forgetting_attention(q, k, v, log_f)
    return jnp.concatenate([ya, yb], axis=-1) @ w_out


def _lin_combine(c1, c2):
    a1, b1 = c1
    a2, b2 = c2
    return a1 * a2, a2 * b1 + b2


def mix_odd(hn, w_in, conv_w, conv_b, w_a, b_a, w_x, b_x, lru_param, w_out):
    b, s, _ = hn.shape
    gate, xr = jnp.split(hn @ w_in, 2, axis=-1)
    xr = causal_conv(xr, conv_w) + conv_b
    xb = xr.reshape(b, s, LRU_HEADS, LRU_BLOCK)
    r = jax.nn.sigmoid(jnp.einsum('bshi,hij->bshj', xb, w_a).reshape(b, s, LRU_WIDTH)
                       .astype(jnp.float32) + b_a.astype(jnp.float32))
    i = jax.nn.sigmoid(jnp.einsum('bshi,hij->bshj', xb, w_x).reshape(b, s, LRU_WIDTH)
                       .astype(jnp.float32) + b_x.astype(jnp.float32))
    log_a = -LRU_C * r * jax.nn.softplus(-lru_param.astype(jnp.float32))
    a = jnp.exp(log_a)
    mult = jnp.sqrt(-jnp.expm1(2.0 * log_a))
    u = mult * (i * xr.astype(jnp.float32))
    _, hs = lax.associative_scan(_lin_combine, (a, u), axis=1)
    y = hs.astype(hn.dtype) * jax.nn.gelu(gate)
    return y @ w_out


def peer(hn, w_query, sub_keys, expert_u, expert_v):
    b, s, d = hn.shape
    tokens = hn.reshape(-1, TOKEN_BLOCK, d)

    def block(xt):
        t = xt.shape[0]
        q = (xt @ w_query).reshape(t, PEER_HEADS, 2, HALF)
        sc = jnp.einsum('thcd,ckd->thck', q, sub_keys).astype(jnp.float32)
        top_s, top_i = lax.top_k(sc, PEER_TOPK)
        cand = top_s[:, :, 0, :, None] + top_s[:, :, 1, None, :]
        best_s, best_c = lax.top_k(cand.reshape(t, PEER_HEADS, PEER_TOPK * PEER_TOPK), PEER_TOPK)
        i1 = jnp.take_along_axis(top_i[:, :, 0], best_c // PEER_TOPK, axis=-1)
        i2 = jnp.take_along_axis(top_i[:, :, 1], best_c % PEER_TOPK, axis=-1)
        idx = (i1 * N_KEYS + i2).reshape(t, PEER_HEADS * PEER_TOPK)
        g = jax.nn.softmax(best_s, axis=-1).reshape(t, PEER_HEADS * PEER_TOPK)
        u = expert_u[idx]
        v = expert_v[idx]
        act = jax.nn.gelu(jnp.einsum('td,tnd->tn', xt, u).astype(jnp.float32))
        return jnp.einsum('tn,tnd->td', (g * act).astype(xt.dtype), v)

    out = lax.map(block, tokens)
    return out.reshape(b, s, d)


def setup_inputs(seed: int = 0) -> dict:
    key = jax.random.key(seed)
    ks = jax.random.split(key, 32)

    def nrm(k, shape, fan_in):
        return jax.random.normal(k, shape, jnp.float32) * (fan_in ** -0.5)

    def gain(k, shape):
        return 1.0 + 0.05 * jax.random.normal(k, shape, jnp.float32)

    def small(k, shape):
        return 0.1 * jax.random.normal(k, shape, jnp.float32)

    rad = jax.random.uniform(ks[19], (N_ODD, LRU_WIDTH), jnp.float32, minval=0.9, maxval=0.999)
    base = rad ** (1.0 / LRU_C)
    lru_param = jnp.log(base) - jnp.log1p(-base)

    return {
        "x": jax.random.normal(ks[0], (BATCH, SEQ, D_MODEL), jnp.float32),
        "p": jax.random.normal(ks[1], (DEPTH, BATCH, SEQ, PLE_DIM), jnp.float32),
        "norm_mix": gain(ks[2], (DEPTH, D_MODEL)),
        "norm_ffn": gain(ks[3], (DEPTH, D_MODEL)),
        "norm_ple": gain(ks[4], (DEPTH, D_MODEL)),
        "even_w_in": nrm(ks[5], (N_EVEN, D_MODEL, EVEN_IN), D_MODEL),
        "even_b_forget": jax.random.uniform(ks[6], (N_EVEN, FOX_HEADS), jnp.float32, minval=1.0, maxval=6.0),
        "even_conv_w": nrm(ks[7], (N_EVEN, CONV_W, CONV_CH), CONV_W),
        "even_q_gain": gain(ks[8], (N_EVEN, FOX_HEAD_DIM)),
        "even_k_gain": gain(ks[9], (N_EVEN, FOX_HEAD_DIM)),
        "even_w_out": nrm(ks[10], (N_EVEN, CONV_CH + FOX_DIM, D_MODEL), CONV_CH + FOX_DIM),
        "odd_w_in": nrm(ks[11], (N_ODD, D_MODEL, 2 * LRU_WIDTH), D_MODEL),
        "odd_conv_w": nrm(ks[12], (N_ODD, LRU_CONV_W, LRU_WIDTH), LRU_CONV_W),
        "odd_conv_b": small(ks[13], (N_ODD, LRU_WIDTH)),
        "odd_w_a": nrm(ks[14], (N_ODD, LRU_HEADS, LRU_BLOCK, LRU_BLOCK), LRU_BLOCK),
        "odd_b_a": small(ks[15], (N_ODD, LRU_WIDTH)),
        "odd_w_x": nrm(ks[16], (N_ODD, LRU_HEADS, LRU_BLOCK, LRU_BLOCK), LRU_BLOCK),
        "odd_b_x": small(ks[17], (N_ODD, LRU_WIDTH)),
        "odd_lru_param": lru_param,
        "odd_w_out": nrm(ks[18], (N_ODD, LRU_WIDTH, D_MODEL), LRU_WIDTH),
        "peer_w_query": nrm(ks[20], (DEPTH, D_MODEL, PEER_HEADS * QUERY_DIM), D_MODEL),
        "peer_sub_keys": nrm(ks[21], (DEPTH, 2, N_KEYS, HALF), HALF),
        "peer_u": nrm(ks[22], (DEPTH, N_EXPERTS, D_MODEL), D_MODEL),
        "peer_v": nrm(ks[23], (DEPTH, N_EXPERTS, D_MODEL), D_MODEL),
        "ple_w_up": nrm(ks[24], (DEPTH, PLE_DIM, D_MODEL), PLE_DIM),
        "ple_w_gate": nrm(ks[25], (DEPTH, D_MODEL, D_MODEL), D_MODEL),
    }


def reference(x, p, norm_mix, norm_ffn, norm_ple, even_w_in, even_b_forget, even_conv_w,
              even_q_gain, even_k_gain, even_w_out, odd_w_in, odd_conv_w, odd_conv_b,
              odd_w_a, odd_b_a, odd_w_x, odd_b_x, odd_lru_param, odd_w_out,
              peer_w_query, peer_sub_keys, peer_u, peer_v, ple_w_up, ple_w_gate):
    h = x
    for layer in range(DEPTH):
        j = layer // 2
        hn = rms_norm(h, norm_mix[layer])
        if layer % 2 == 0:
            h = h + mix_even(hn, even_w_in[j], even_b_forget[j], even_conv_w[j],
                             even_q_gain[j], even_k_gain[j], even_w_out[j])
        else:
            h = h + mix_odd(hn, odd_w_in[j], odd_conv_w[j], odd_conv_b[j], odd_w_a[j],
                            odd_b_a[j], odd_w_x[j], odd_b_x[j], odd_lru_param[j], odd_w_out[j])
        h = h + peer(rms_norm(h, norm_ffn[layer]), peer_w_query[layer], peer_sub_keys[layer],
                     peer_u[layer], peer_v[layer])
        gate = jax.nn.sigmoid(rms_norm(h, norm_ple[layer]) @ ple_w_gate[layer])
        h = h + (p[layer] @ ple_w_up[layer]) * gate
    return h
```

```cpp
#include <hip/hip_runtime.h>
#include <hip/hip_cooperative_groups.h>
#include <stdint.h>
#include <cstdio>
namespace cg = cooperative_groups;

typedef unsigned short bf16_t;
typedef short bf16x8 __attribute__((ext_vector_type(8)));
typedef float f32x16 __attribute__((ext_vector_type(16)));
typedef float f32x4 __attribute__((ext_vector_type(4)));
typedef unsigned u32x4 __attribute__((ext_vector_type(4)));
typedef unsigned u32x2 __attribute__((ext_vector_type(2)));
typedef float f32x2_t __attribute__((ext_vector_type(2)));
typedef __bf16 bf16x2_t __attribute__((ext_vector_type(2)));
#define DEV __device__ __forceinline__

constexpr int T_TOK = 32768, SEQ = 16384, DM = 1024, NPANEL = 256;
constexpr float EPS = 1e-6f, LOG2E = 1.4426950408889634f;
constexpr size_t MB = 1u << 20;
constexpr size_t WS_FLOC = 0;
constexpr size_t WS_PTOT = 1 * MB;
constexpr size_t WS_APROD = 2 * MB;
constexpr size_t WS_HEND = 3 * MB;
constexpr size_t WS_W = 4 * MB;
constexpr size_t W_IN0 = WS_W, W_OUT0 = WS_W + 6 * MB, W_IN1 = WS_W + 8 * MB, W_AX = WS_W + 12 * MB, W_OUT1 = WS_W + 13 * MB,
                 W_QB = WS_W + 15 * MB, W_SK = WS_W + 23 * MB, W_PT = WS_W + 24 * MB, W_UP = WS_W + 32 * MB, W_GATE = WS_W + 33 * MB;
constexpr size_t WS_TAB = 44 * MB;
constexpr size_t WS_PB = 172 * MB;
constexpr size_t WS_HN = 204 * MB;
constexpr size_t WS_Z = 268 * MB;
constexpr size_t WS_VT = 460 * MB;
constexpr size_t WS_END = 492 * MB;
constexpr size_t SLICE = 768 * 1024;

constexpr int LDS_BYTES = 131072;
constexpr int LROW = 144;
constexpr int G_B = 128 * LROW, G_STAGE = 384 * LROW;
constexpr int LDS_MISC = 2 * G_STAGE;

extern __shared__ __attribute__((aligned(16))) unsigned char smem[];

struct Params {
  const float *x, *p, *norm_mix, *norm_ffn, *norm_ple, *even_w_in, *even_b_forget, *even_conv_w, *even_q_gain, *even_k_gain, *even_w_out,
      *odd_w_in, *odd_conv_w, *odd_conv_b, *odd_w_a, *odd_b_a, *odd_w_x, *odd_b_x, *odd_lru, *odd_w_out,
      *peer_wq, *peer_sk, *peer_u, *peer_v, *ple_up, *ple_gate;
  float* out; unsigned char* ws;
};

DEV unsigned pk2(float lo, float hi) { f32x2_t v = {lo, hi}; bf16x2_t b = __builtin_convertvector(v, bf16x2_t); return __builtin_bit_cast(unsigned, b); }
DEV float bflo(unsigned u) { return __uint_as_float(u << 16); }
DEV float bfhi(unsigned u) { return __uint_as_float(u & 0xffff0000u); }
DEV float bf2f(bf16_t v) { return __uint_as_float((unsigned)v << 16); }
DEV bf16_t f2bf(float f) { return (bf16_t)(pk2(f, 0.f) & 0xffffu); }
DEV float wave_sum(float v) {
#pragma unroll
  for (int o = 1; o < 64; o <<= 1) v += __shfl_xor(v, o);
  return v;
}
DEV float gelu_tanh(float x) { const float u = 1.5957691216057308f * (x + 0.044715f * x * x * x); return x / (1.f + __expf(-u)); }
DEV float sigmoidf_(float x) { return 1.f / (1.f + __expf(-x)); }

DEV int tid_l() { int t = threadIdx.x; asm volatile("" : "+v"(t)); return t; }
DEV void gemm_kloop(f32x16 (&acc)[2][2], const bf16_t* A, int lda, const bf16_t* Bt, int ldb, int K) {
  const int tid = tid_l(), lane = tid & 63, wid = tid >> 6, wm = wid & 1, wn = wid >> 1, l32 = lane & 31, hi = lane >> 5;
  const int c = tid & 7, r = tid >> 3;
  const bf16_t* ga = A + (size_t)r * lda + c * 8;
  const bf16_t* gb = Bt + (size_t)r * ldb + c * 8;
  const int sa = r * LROW + c * 16, sb = G_B + r * LROW + c * 16;
  const int xa = (64 * wm + l32) * LROW + hi * 16, wb = G_B + (64 * wn + l32) * LROW + hi * 16;
  u32x4 ra[2], rb[4];
  const int nk = K >> 6;
  __syncthreads();
#pragma unroll
  for (int i = 0; i < 2; ++i) ra[i] = *(const u32x4*)(ga + (size_t)i * 64 * lda);
#pragma unroll
  for (int i = 0; i < 4; ++i) rb[i] = *(const u32x4*)(gb + (size_t)i * 64 * ldb);
#pragma unroll
  for (int i = 0; i < 2; ++i) *(u32x4*)(smem + sa + i * 64 * LROW) = ra[i];
#pragma unroll
  for (int i = 0; i < 4; ++i) *(u32x4*)(smem + sb + i * 64 * LROW) = rb[i];
  __syncthreads();
#pragma nounroll
  for (int kt = 0; kt < nk; ++kt) {
    const int st = (kt & 1) * G_STAGE;
    const bool more = kt + 1 < nk;
    if (more) {
      ga += 64; gb += 64;
#pragma unroll
      for (int i = 0; i < 2; ++i) ra[i] = *(const u32x4*)(ga + (size_t)i * 64 * lda);
#pragma unroll
      for (int i = 0; i < 4; ++i) rb[i] = *(const u32x4*)(gb + (size_t)i * 64 * ldb);
    }
#pragma unroll
    for (int ks = 0; ks < 4; ++ks) {
      bf16x8 xf[2], wf[2];
#pragma unroll
      for (int mb = 0; mb < 2; ++mb) xf[mb] = *(const bf16x8*)(smem + st + xa + mb * 32 * LROW + ks * 32);
#pragma unroll
      for (int nb = 0; nb < 2; ++nb) wf[nb] = *(const bf16x8*)(smem + st + wb + nb * 32 * LROW + ks * 32);
#pragma unroll
      for (int nb = 0; nb < 2; ++nb)
#pragma unroll
        for (int mb = 0; mb < 2; ++mb) acc[nb][mb] = __builtin_amdgcn_mfma_f32_32x32x16_bf16(wf[nb], xf[mb], acc[nb][mb], 0, 0, 0);
    }
    if (more) {
      const int so = st ^ G_STAGE;
#pragma unroll
      for (int i = 0; i < 2; ++i) *(u32x4*)(smem + so + sa + i * 64 * LROW) = ra[i];
#pragma unroll
      for (int i = 0; i < 4; ++i) *(u32x4*)(smem + so + sb + i * 64 * LROW) = rb[i];
    }
    __syncthreads();
  }
}
DEV void acc_zero(f32x16 (&acc)[2][2]) {
#pragma unroll
  for (int a = 0; a < 2; ++a)
#pragma unroll
    for (int b = 0; b < 2; ++b)
#pragma unroll
      for (int r = 0; r < 16; ++r) acc[a][b][r] = 0.f;
}
#define GEO const int tid = tid_l(), lane = tid & 63, wid = tid >> 6, wm = wid & 1, wn = wid >> 1, l32 = lane & 31, hi = lane >> 5; (void)wm; (void)wn; (void)l32; (void)hi; (void)lane; (void)wid;
#define FOR_ACC _Pragma("unroll") for (int nb = 0; nb < 2; ++nb) _Pragma("unroll") for (int mb = 0; mb < 2; ++mb) _Pragma("unroll") for (int rq = 0; rq < 4; ++rq)

DEV void transpose_job(const float* __restrict__ W, int K, int N, int ldw, bf16_t* Wt, int ldt) {
  float* tile = (float*)smem;
  const int tid = threadIdx.x; const int ntn = N >> 6, ntiles = (K >> 6) * ntn;
  for (int t = blockIdx.x; t < ntiles; t += gridDim.x) {
    const int k0 = (t / ntn) << 6, n0 = (t % ntn) << 6;
    __syncthreads();
#pragma unroll
    for (int q = 0; q < 2; ++q) {
      const int id = tid + q * 512, i = id >> 4, c4 = (id & 15) << 2;
      const f32x4 v = *(const f32x4*)(W + (size_t)(k0 + i) * ldw + n0 + c4);
      tile[i * 65 + c4 + 0] = v[0]; tile[i * 65 + c4 + 1] = v[1]; tile[i * 65 + c4 + 2] = v[2]; tile[i * 65 + c4 + 3] = v[3];
    }
    __syncthreads();
    const int n = tid >> 3, kc = (tid & 7) << 3;
    u32x4 o;
    o[0] = pk2(tile[(kc + 0) * 65 + n], tile[(kc + 1) * 65 + n]); o[1] = pk2(tile[(kc + 2) * 65 + n], tile[(kc + 3) * 65 + n]);
    o[2] = pk2(tile[(kc + 4) * 65 + n], tile[(kc + 5) * 65 + n]); o[3] = pk2(tile[(kc + 6) * 65 + n], tile[(kc + 7) * 65 + n]);
    *(u32x4*)(Wt + (size_t)(n0 + n) * ldt + k0 + kc) = o;
  }
  __syncthreads();
}
DEV void convert_job(const float* __restrict__ src, bf16_t* dst, size_t n) {
  const size_t stride = (size_t)gridDim.x * 512 * 8;
  for (size_t i = ((size_t)blockIdx.x * 512 + threadIdx.x) * 8; i < n; i += stride) {
    const f32x4 a = *(const f32x4*)(src + i), b = *(const f32x4*)(src + i + 4);
    u32x4 o; o[0] = pk2(a[0], a[1]); o[1] = pk2(a[2], a[3]); o[2] = pk2(b[0], b[1]); o[3] = pk2(b[2], b[3]);
    *(u32x4*)(dst + i) = o;
  }
}

DEV void panel_rmsnorm(const float* src, const float* __restrict__ gain, bf16_t* dst, int m0) {
  GEO
  f32x4 g[4];
#pragma unroll
  for (int j = 0; j < 4; ++j) g[j] = *(const f32x4*)(gain + j * 256 + lane * 4);
#pragma nounroll
  for (int i = 0; i < 16; ++i) {
    const size_t row = (size_t)(m0 + wid * 16 + i) * DM;
    f32x4 v[4]; float s = 0.f;
#pragma unroll
    for (int j = 0; j < 4; ++j) { v[j] = *(const f32x4*)(src + row + j * 256 + lane * 4); s += v[j][0] * v[j][0] + v[j][1] * v[j][1] + v[j][2] * v[j][2] + v[j][3] * v[j][3]; }
    const float rstd = rsqrtf(wave_sum(s) * (1.f / DM) + EPS);
#pragma unroll
    for (int j = 0; j < 4; ++j) {
      u32x2 o; o[0] = pk2(v[j][0] * rstd * g[j][0], v[j][1] * rstd * g[j][1]); o[1] = pk2(v[j][2] * rstd * g[j][2], v[j][3] * rstd * g[j][3]);
      *(u32x2*)(dst + row + j * 256 + lane * 4) = o;
    }
  }
}

DEV void p1_panel(const Params& P, int p) {
  GEO
  const int m0 = p * 128;
  bf16_t* hn = (bf16_t*)(P.ws + WS_HN);
  bf16_t* z = (bf16_t*)(P.ws + WS_Z);
  bf16_t* vt = (bf16_t*)(P.ws + WS_VT);
  float* floc = (float*)(P.ws + WS_FLOC);
  float* ptot = (float*)(P.ws + WS_PTOT);
  float* lf = (float*)(smem + LDS_MISC);
  {
    float wfr[4][4][8]; f32x4 g[4];
#pragma unroll
    for (int j = 0; j < 4; ++j) {
      g[j] = *(const f32x4*)(P.norm_mix + j * 256 + lane * 4);
#pragma unroll
      for (int e = 0; e < 4; ++e) {
        const float* wp = P.even_w_in + (size_t)(j * 256 + lane * 4 + e) * 3080 + 3072;
        const f32x4 a = *(const f32x4*)wp, b = *(const f32x4*)(wp + 4);
        wfr[j][e][0] = a[0]; wfr[j][e][1] = a[1]; wfr[j][e][2] = a[2]; wfr[j][e][3] = a[3];
        wfr[j][e][4] = b[0]; wfr[j][e][5] = b[1]; wfr[j][e][6] = b[2]; wfr[j][e][7] = b[3];
      }
    }
  #pragma nounroll
  for (int i = 0; i < 16; ++i) {
      const size_t row = (size_t)(m0 + wid * 16 + i) * DM;
      f32x4 v[4]; float s = 0.f;
#pragma unroll
      for (int j = 0; j < 4; ++j) { v[j] = *(const f32x4*)(P.x + row + j * 256 + lane * 4); s += v[j][0] * v[j][0] + v[j][1] * v[j][1] + v[j][2] * v[j][2] + v[j][3] * v[j][3]; }
      const float rstd = rsqrtf(wave_sum(s) * (1.f / DM) + EPS);
      float fs[8];
#pragma unroll
      for (int h = 0; h < 8; ++h) fs[h] = 0.f;
#pragma unroll
      for (int j = 0; j < 4; ++j) {
        float hv[4];
#pragma unroll
        for (int e = 0; e < 4; ++e) {
          hv[e] = v[j][e] * rstd * g[j][e];
#pragma unroll
          for (int h = 0; h < 8; ++h) fs[h] += hv[e] * wfr[j][e][h];
        }
        u32x2 o; o[0] = pk2(hv[0], hv[1]); o[1] = pk2(hv[2], hv[3]);
        *(u32x2*)(hn + row + j * 256 + lane * 4) = o;
      }
#pragma unroll
      for (int h = 0; h < 8; ++h) fs[h] = wave_sum(fs[h]);
      if (lane < 8) {
        float f = fs[0];
#pragma unroll
        for (int h = 1; h < 8; ++h) f = (lane == h) ? fs[h] : f;
        const float xx = f + P.even_b_forget[lane];
        lf[(wid * 16 + i) * 8 + lane] = fminf(xx, 0.f) - log1pf(__expf(-fabsf(xx)));
      }
    }
  }
  __syncthreads();
  if (tid < 8) {
    const int b = m0 / SEQ, s0 = m0 % SEQ;
    float cum = 0.f; float* fo = floc + (size_t)(b * 8 + tid) * SEQ + s0;
    for (int t = 0; t < 128; ++t) { cum += lf[t * 8 + tid]; fo[t] = cum; }
    ptot[p * 8 + tid] = cum;
  }
  const bf16_t* wt = (const bf16_t*)(P.ws + W_IN0);
#pragma nounroll
  for (int nt = 0; nt < 12; ++nt) {
    f32x16 acc[2][2]; acc_zero(acc);
    gemm_kloop(acc, hn + (size_t)m0 * DM, DM, wt + (size_t)nt * 256 * DM, DM, DM);
    const int n0 = nt * 256;
    if (nt < 6) {
      FOR_ACC {
        const int tok = m0 + 64 * wm + 32 * mb + l32, col = n0 + 64 * wn + 32 * nb + 8 * rq + 4 * hi;
        u32x2 o; o[0] = pk2(acc[nb][mb][4 * rq], acc[nb][mb][4 * rq + 1]); o[1] = pk2(acc[nb][mb][4 * rq + 2], acc[nb][mb][4 * rq + 3]);
        *(u32x2*)(z + (size_t)tok * 3072 + col) = o;
      }
    } else if (nt < 10) {
      const bool isq = nt < 8;
      const float* gn = isq ? P.even_q_gain : P.even_k_gain;
      const float extra = isq ? 0.125f * LOG2E : 1.f;
#pragma unroll
      for (int mb = 0; mb < 2; ++mb) {
        float s = 0.f;
#pragma unroll
        for (int nb = 0; nb < 2; ++nb)
#pragma unroll
          for (int r = 0; r < 16; ++r) s += acc[nb][mb][r] * acc[nb][mb][r];
        s += __shfl_xor(s, 32);
        const float rstd = rsqrtf(s * (1.f / 64.f) + EPS) * extra;
        const int tok = m0 + 64 * wm + 32 * mb + l32;
#pragma unroll
        for (int nb = 0; nb < 2; ++nb)
#pragma unroll
          for (int rq = 0; rq < 4; ++rq) {
            const int cl = 32 * nb + 8 * rq + 4 * hi;
            const f32x4 gg = *(const f32x4*)(gn + cl);
            u32x2 o; o[0] = pk2(acc[nb][mb][4 * rq] * rstd * gg[0], acc[nb][mb][4 * rq + 1] * rstd * gg[1]);
            o[1] = pk2(acc[nb][mb][4 * rq + 2] * rstd * gg[2], acc[nb][mb][4 * rq + 3] * rstd * gg[3]);
            *(u32x2*)(z + (size_t)tok * 3072 + n0 + 64 * wn + cl) = o;
          }
      }
    } else {
      FOR_ACC {
        const int tok = m0 + 64 * wm + 32 * mb + l32, col = n0 + 64 * wn + 32 * nb + 8 * rq + 4 * hi - 2560;
        const int b = tok / SEQ, s = tok % SEQ;
#pragma unroll
        for (int e = 0; e < 4; ++e) vt[(size_t)(b * 512 + col + e) * SEQ + s] = f2bf(acc[nb][mb][4 * rq + e]);
      }
    }
  }
}
DEV void fold_unit(const Params& P, int u) {
  GEO
  const int l = u >> 6, jt = (u >> 3) & 7, hh = u & 7;
  const bf16_t* A = (const bf16_t*)(P.ws + W_QB) + (size_t)l * 1024 * 2048 + (size_t)(jt * 128) * 2048 + hh * 256;
  const bf16_t* Bt = (const bf16_t*)(P.ws + W_SK) + (size_t)l * 65536;
  bf16_t* wpt = (bf16_t*)(P.ws + W_PT);
  f32x16 acc[2][2]; acc_zero(acc);
  gemm_kloop(acc, A, 2048, Bt, 256, 256);
  FOR_ACC {
    const int j = jt * 128 + 64 * wm + 32 * mb + l32, n = 64 * wn + 32 * nb + 8 * rq + 4 * hi;
#pragma unroll
    for (int e = 0; e < 4; ++e) wpt[((size_t)l * 2048 + hh * 256 + n + e) * 1024 + j] = f2bf(acc[nb][mb][4 * rq + e]);
  }
}

constexpr int AT_K = 0, AT_V = 64 * LROW, AT_BIAS = 128 * LROW, AT_STG = 128 * LROW + 256;
constexpr int AT_GRP = 2 * AT_STG;
constexpr int AT_SUF = 2 * AT_GRP;
DEV int crow(int r, int hi) { return 8 * (r >> 2) + 4 * hi + (r & 3); }

DEV void attn_unit(const Params& P, int b, int qb, int hp) {
  const int tid = threadIdx.x, lane = tid & 63, wid = tid >> 6, l32 = lane & 31, hi = lane >> 5;
  const int g = wid >> 2, wq = wid & 3, h = 2 * hp + g, gt = tid & 255;
  const bf16_t* z = (const bf16_t*)(P.ws + WS_Z);
  const bf16_t* vt = (const bf16_t*)(P.ws + WS_VT);
  bf16_t* ycat = (bf16_t*)(P.ws + WS_HN);
  const float* fl = (const float*)(P.ws + WS_FLOC) + (size_t)(b * 8 + h) * SEQ;
  const float* ptot = (const float*)(P.ws + WS_PTOT);
  float* suf = (float*)(smem + AT_SUF) + g * 128;
  __syncthreads();
  float val = 0.f;
  if (gt < 128) { val = (gt < qb) ? ptot[(b * 128 + gt) * 8 + h] : 0.f; suf[gt] = val; }
#pragma nounroll
  for (int off = 1; off < 128; off <<= 1) {
    __syncthreads();
    float v2 = 0.f;
    if (gt < 128 && gt + off < 128) v2 = suf[gt + off];
    __syncthreads();
    if (gt < 128) { val += v2; suf[gt] = val; }
  }
  __syncthreads();
  const int tokq = b * SEQ + qb * 128 + wq * 32 + l32;
  bf16x8 qf[4];
#pragma unroll
  for (int d0 = 0; d0 < 4; ++d0) qf[d0] = *(const bf16x8*)(z + (size_t)tokq * 3072 + 1536 + h * 64 + d0 * 16 + hi * 8);
  const float fend = fl[qb * 128 + 127];
  const int kc = gt & 7, kr = gt >> 3;
  const bf16_t* kg = z + (size_t)(b * SEQ + kr) * 3072 + 2048 + h * 64 + kc * 8;
  const bf16_t* vg = vt + (size_t)((b * 8 + h) * 64 + kr) * SEQ + kc * 8;
  const int gbase = g * AT_GRP;
  const int sk_ = kr * LROW + kc * 16;
  const int NT = 2 * qb + 2;
  u32x4 rk[2], rv[2]; float rbias = 0.f;
#define AT_LOAD(t) do { \
    rk[0] = *(const u32x4*)(kg + (size_t)(t) * 64 * 3072); rk[1] = *(const u32x4*)(kg + (size_t)((t) * 64 + 32) * 3072); \
    rv[0] = *(const u32x4*)(vg + (t) * 64); rv[1] = *(const u32x4*)(vg + (size_t)32 * SEQ + (t) * 64); \
    if (gt < 64) { const int j_ = (t) * 64 + gt; rbias = (fend - fl[j_] + suf[j_ >> 7]) * LOG2E; } } while (0)
#define AT_STORE(st) do { \
    *(u32x4*)(smem + (st) + AT_K + sk_) = rk[0]; *(u32x4*)(smem + (st) + AT_K + sk_ + 32 * LROW) = rk[1]; \
    *(u32x4*)(smem + (st) + AT_V + sk_) = rv[0]; *(u32x4*)(smem + (st) + AT_V + sk_ + 32 * LROW) = rv[1]; \
    if (gt < 64) *(float*)(smem + (st) + AT_BIAS + gt * 4) = rbias; } while (0)
  AT_LOAD(0);
  AT_STORE(gbase);
  __syncthreads();
  float m = -INFINITY, l = 0.f;
  f32x16 o[2];
#pragma unroll
  for (int r = 0; r < 16; ++r) { o[0][r] = 0.f; o[1][r] = 0.f; }
#pragma nounroll
  for (int t = 0; t < NT; ++t) {
    const int st = gbase + (t & 1) * AT_STG;
    const bool more = t + 1 < NT;
    if (more) AT_LOAD(t + 1);
    const bool active = !(t == 2 * qb + 1 && wq < 2);
    if (active) {
      f32x16 s0, s1;
#pragma unroll
      for (int r = 0; r < 16; ++r) { s0[r] = 0.f; s1[r] = 0.f; }
#pragma unroll
      for (int d0 = 0; d0 < 4; ++d0) {
        const bf16x8 k0 = *(const bf16x8*)(smem + st + AT_K + l32 * LROW + d0 * 32 + hi * 16);
        const bf16x8 k1 = *(const bf16x8*)(smem + st + AT_K + (32 + l32) * LROW + d0 * 32 + hi * 16);
        s0 = __builtin_amdgcn_mfma_f32_32x32x16_bf16(k0, qf[d0], s0, 0, 0, 0);
        s1 = __builtin_amdgcn_mfma_f32_32x32x16_bf16(k1, qf[d0], s1, 0, 0, 0);
      }
#pragma unroll
      for (int rq = 0; rq < 4; ++rq) {
        const f32x4 b0 = *(const f32x4*)(smem + st + AT_BIAS + (8 * rq + 4 * hi) * 4);
        const f32x4 b1 = *(const f32x4*)(smem + st + AT_BIAS + (32 + 8 * rq + 4 * hi) * 4);
#pragma unroll
        for (int e = 0; e < 4; ++e) { s0[4 * rq + e] += b0[e]; s1[4 * rq + e] += b1[e]; }
      }
      if (t >= 2 * qb) {
        const int kb = 64 * (t - 2 * qb), qrel = 32 * wq + l32;
#pragma unroll
        for (int r = 0; r < 16; ++r) {
          const int kv = kb + crow(r, hi);
          if (kv > qrel) s0[r] = -INFINITY;
          if (kv + 32 > qrel) s1[r] = -INFINITY;
        }
      }
      float mx = s0[0];
#pragma unroll
      for (int r = 1; r < 16; ++r) mx = fmaxf(mx, s0[r]);
#pragma unroll
      for (int r = 0; r < 16; ++r) mx = fmaxf(mx, s1[r]);
      mx = fmaxf(mx, __shfl_xor(mx, 32));
      const float mn = fmaxf(m, mx);
      const float alpha = __builtin_amdgcn_exp2f(m - mn);
      m = mn;
      float ls = 0.f;
#pragma unroll
      for (int r = 0; r < 16; ++r) { s0[r] = __builtin_amdgcn_exp2f(s0[r] - mn); s1[r] = __builtin_amdgcn_exp2f(s1[r] - mn); ls += s0[r] + s1[r]; }
      l = l * alpha + ls;
#pragma unroll
      for (int r = 0; r < 16; ++r) { o[0][r] *= alpha; o[1][r] *= alpha; }
      bf16x8 pf[2][2];
#pragma unroll
      for (int ks = 0; ks < 2; ++ks) {
        u32x4 a, c;
        a[0] = pk2(s0[8 * ks + 0], s0[8 * ks + 1]); a[1] = pk2(s0[8 * ks + 2], s0[8 * ks + 3]); a[2] = pk2(s0[8 * ks + 4], s0[8 * ks + 5]); a[3] = pk2(s0[8 * ks + 6], s0[8 * ks + 7]);
        c[0] = pk2(s1[8 * ks + 0], s1[8 * ks + 1]); c[1] = pk2(s1[8 * ks + 2], s1[8 * ks + 3]); c[2] = pk2(s1[8 * ks + 4], s1[8 * ks + 5]); c[3] = pk2(s1[8 * ks + 6], s1[8 * ks + 7]);
        pf[0][ks] = __builtin_bit_cast(bf16x8, a); pf[1][ks] = __builtin_bit_cast(bf16x8, c);
      }
#pragma unroll
      for (int pbk = 0; pbk < 2; ++pbk)
#pragma unroll
        for (int ks = 0; ks < 2; ++ks)
#pragma unroll
          for (int db = 0; db < 2; ++db) {
            const int off = st + AT_V + (32 * db + l32) * LROW + (32 * pbk + 16 * ks + 4 * hi) * 2;
            const u32x2 lo = *(const u32x2*)(smem + off), hh = *(const u32x2*)(smem + off + 16);
            u32x4 vv; vv[0] = lo[0]; vv[1] = lo[1]; vv[2] = hh[0]; vv[3] = hh[1];
            o[db] = __builtin_amdgcn_mfma_f32_32x32x16_bf16(__builtin_bit_cast(bf16x8, vv), pf[pbk][ks], o[db], 0, 0, 0);
          }
    }
    if (more) AT_STORE(gbase + ((t + 1) & 1) * AT_STG);
    __syncthreads();
  }
#undef AT_LOAD
#undef AT_STORE
  l += __shfl_xor(l, 32);
  const float inv = 1.f / l;
#pragma unroll
  for (int db = 0; db < 2; ++db)
#pragma unroll
    for (int rq = 0; rq < 4; ++rq) {
      u32x2 ov; ov[0] = pk2(o[db][4 * rq] * inv, o[db][4 * rq + 1] * inv); ov[1] = pk2(o[db][4 * rq + 2] * inv, o[db][4 * rq + 3] * inv);
      *(u32x2*)(ycat + (size_t)tokq * DM + 512 + h * 64 + 32 * db + 8 * rq + 4 * hi) = ov;
    }
}
DEV void conv_mixer(const Params& P, int p) {
  const int c = threadIdx.x, m0 = p * 128, s0 = m0 % SEQ;
  const bf16_t* z = (const bf16_t*)(P.ws + WS_Z);
  bf16_t* ycat = (bf16_t*)(P.ws + WS_HN);
  const float w0 = P.even_conv_w[c], w1 = P.even_conv_w[512 + c], w2 = P.even_conv_w[1024 + c];
  float g2 = 0.f, g1 = 0.f;
  if (s0 > 0) {
    const bf16_t* r2 = z + (size_t)(m0 - 2) * 3072, *r1 = z + (size_t)(m0 - 1) * 3072;
    g2 = bf2f(r2[512 + c]) * bf2f(r2[1024 + c]); g1 = bf2f(r1[512 + c]) * bf2f(r1[1024 + c]);
  }
  for (int t = 0; t < 128; ++t) {
    const bf16_t* r = z + (size_t)(m0 + t) * 3072;
    const float g0 = bf2f(r[512 + c]) * bf2f(r[1024 + c]);
    const float y = bf2f(r[c]) * (w0 * g2 + w1 * g1 + w2 * g0);
    ycat[(size_t)(m0 + t) * DM + c] = f2bf(y);
    g2 = g1; g1 = g0;
  }
}

DEV unsigned fkey(float x) { const unsigned u = __float_as_uint(x); return (u & 0x80000000u) ? ~u : (u | 0x80000000u); }
DEV float keyf(unsigned k) { const unsigned u = (k & 0x80000000u) ? (k & 0x7fffffffu) : ~k; return __uint_as_float(u); }
DEV void ins16(unsigned (&L)[16], unsigned key) {
#pragma unroll
  for (int j = 0; j < 16; ++j) { const unsigned a = L[j]; L[j] = max(a, key); key = min(a, key); }
}
DEV void stage1(unsigned (&L)[16], const float* sp) {
#pragma unroll
  for (int j = 0; j < 16; ++j) L[j] = 0u;
#pragma nounroll
  for (int i = 0; i < 128; i += 8) {
    float v[8];
#pragma unroll
    for (int e = 0; e < 8; ++e) v[e] = sp[(size_t)(i + e) * 128];
#pragma unroll
    for (int e = 0; e < 8; ++e) ins16(L, (fkey(v[e]) & ~127u) | (unsigned)(127 - (i + e)));
  }
}
DEV void topk_group(int hg, const float* scoresT, int* idxo, float* go) {
  const int tid = threadIdx.x, token = tid & 127, hl = tid >> 7;
  unsigned LA[16], LB[16], LC[16];
  stage1(LA, scoresT + (size_t)(hl * 256) * 128 + token);
  stage1(LB, scoresT + (size_t)(hl * 256 + 128) * 128 + token);
  unsigned* la = (unsigned*)smem; unsigned* lb = la + 16 * 512;
  float bv[16];
#pragma unroll
  for (int j = 0; j < 16; ++j) { LC[j] = 0u; bv[j] = keyf(LB[j] & ~127u); la[j * 512 + tid] = LA[j]; lb[j * 512 + tid] = LB[j]; }
#pragma unroll
  for (int i = 0; i < 16; ++i) {
    const float av = keyf(LA[i] & ~127u);
#pragma unroll
    for (int j = 0; j < 16; ++j)
      if ((i + 1) * (j + 1) <= 16) ins16(LC, (fkey(av + bv[j]) & ~255u) | (unsigned)(255 - (i * 16 + j)));
  }
  const float smax = keyf(LC[0] & ~255u);
  float ev[16], sum = 0.f;
#pragma unroll
  for (int k = 0; k < 16; ++k) { ev[k] = __expf(keyf(LC[k] & ~255u) - smax); sum += ev[k]; }
  const float inv = 1.f / sum;
  const int head = hg * 4 + hl;
#pragma unroll
  for (int k = 0; k < 16; ++k) {
    const int c = 255 - (int)(LC[k] & 255u), i = c >> 4, j = c & 15;
    const int i1 = 127 - (int)(la[i * 512 + tid] & 127u), i2 = 127 - (int)(lb[j * 512 + tid] & 127u);
    idxo[token * 128 + head * 16 + k] = i1 * 128 + i2;
    go[token * 128 + head * 16 + k] = ev[k] * inv;
  }
}
DEV void peer_gather(const Params& P, int l, int m0, const int* idxs, const float* gs) {
  const int tid = threadIdx.x, lane = tid & 63, wid = tid >> 6;
  const bf16_t* U = (const bf16_t*)(P.ws + WS_TAB) + (size_t)l * 2 * 16384 * 1024;
  const bf16_t* V = U + (size_t)16384 * 1024;
  bf16_t* hn = (bf16_t*)(P.ws + WS_HN);
  const float* gp = P.norm_ple + l * DM;
#pragma nounroll
  for (int i = 0; i < 16; ++i) {
    const int tt = wid * 16 + i; const size_t tok = (size_t)(m0 + tt);
    const u32x4 xa = *(const u32x4*)(hn + tok * DM + lane * 8), xb = *(const u32x4*)(hn + tok * DM + 512 + lane * 8);
    float xv[16];
#pragma unroll
    for (int q = 0; q < 4; ++q) { xv[2 * q] = bflo(xa[q]); xv[2 * q + 1] = bfhi(xa[q]); xv[8 + 2 * q] = bflo(xb[q]); xv[8 + 2 * q + 1] = bfhi(xb[q]); }
    const int myi0 = idxs[tt * 128 + lane], myi1 = idxs[tt * 128 + 64 + lane];
    const float myg0 = gs[tt * 128 + lane], myg1 = gs[tt * 128 + 64 + lane];
    float acc[16];
#pragma unroll
    for (int q = 0; q < 16; ++q) acc[q] = 0.f;
#pragma nounroll
    for (int e0 = 0; e0 < 128; e0 += 4) {
      u32x4 ur[4][2], vr[4][2]; float gg[4];
      const int isrc = (e0 < 64) ? myi0 : myi1; const float gsrc = (e0 < 64) ? myg0 : myg1;
#pragma unroll
      for (int e = 0; e < 4; ++e) {
        const int ln = (e0 + e) & 63;
        const int idx = __builtin_amdgcn_readlane(isrc, ln);
        gg[e] = __uint_as_float(__builtin_amdgcn_readlane(__float_as_uint(gsrc), ln));
        const bf16_t* up = U + (size_t)idx * 1024 + lane * 8; const bf16_t* vp = V + (size_t)idx * 1024 + lane * 8;
        ur[e][0] = *(const u32x4*)up; ur[e][1] = *(const u32x4*)(up + 512);
        vr[e][0] = *(const u32x4*)vp; vr[e][1] = *(const u32x4*)(vp + 512);
      }
#pragma unroll
      for (int e = 0; e < 4; ++e) {
        float d = 0.f;
#pragma unroll
        for (int q = 0; q < 4; ++q) {
          d += xv[2 * q] * bflo(ur[e][0][q]) + xv[2 * q + 1] * bfhi(ur[e][0][q]);
          d += xv[8 + 2 * q] * bflo(ur[e][1][q]) + xv[8 + 2 * q + 1] * bfhi(ur[e][1][q]);
        }
        d = wave_sum(d);
        const float w = gg[e] * gelu_tanh(d);
#pragma unroll
        for (int q = 0; q < 4; ++q) {
          acc[2 * q] += w * bflo(vr[e][0][q]); acc[2 * q + 1] += w * bfhi(vr[e][0][q]);
          acc[8 + 2 * q] += w * bflo(vr[e][1][q]); acc[8 + 2 * q + 1] += w * bfhi(vr[e][1][q]);
        }
      }
    }
    float* hrow = P.out + tok * DM;
    f32x4 h0 = *(const f32x4*)(hrow + lane * 8), h1 = *(const f32x4*)(hrow + lane * 8 + 4), h2 = *(const f32x4*)(hrow + 512 + lane * 8), h3 = *(const f32x4*)(hrow + 512 + lane * 8 + 4);
    float ss = 0.f;
#pragma unroll
    for (int q = 0; q < 4; ++q) { h0[q] += acc[q]; h1[q] += acc[4 + q]; h2[q] += acc[8 + q]; h3[q] += acc[12 + q]; ss += h0[q] * h0[q] + h1[q] * h1[q] + h2[q] * h2[q] + h3[q] * h3[q]; }
    *(f32x4*)(hrow + lane * 8) = h0; *(f32x4*)(hrow + lane * 8 + 4) = h1; *(f32x4*)(hrow + 512 + lane * 8) = h2; *(f32x4*)(hrow + 512 + lane * 8 + 4) = h3;
    const float rstd = rsqrtf(wave_sum(ss) * (1.f / DM) + EPS);
    const f32x4 g0 = *(const f32x4*)(gp + lane * 8), g1 = *(const f32x4*)(gp + lane * 8 + 4), g2 = *(const f32x4*)(gp + 512 + lane * 8), g3 = *(const f32x4*)(gp + 512 + lane * 8 + 4);
    u32x4 oa, ob;
    oa[0] = pk2(h0[0] * rstd * g0[0], h0[1] * rstd * g0[1]); oa[1] = pk2(h0[2] * rstd * g0[2], h0[3] * rstd * g0[3]);
    oa[2] = pk2(h1[0] * rstd * g1[0], h1[1] * rstd * g1[1]); oa[3] = pk2(h1[2] * rstd * g1[2], h1[3] * rstd * g1[3]);
    ob[0] = pk2(h2[0] * rstd * g2[0], h2[1] * rstd * g2[1]); ob[1] = pk2(h2[2] * rstd * g2[2], h2[3] * rstd * g2[3]);
    ob[2] = pk2(h3[0] * rstd * g3[0], h3[1] * rstd * g3[1]); ob[3] = pk2(h3[2] * rstd * g3[2], h3[3] * rstd * g3[3]);
    *(u32x4*)(hn + tok * DM + lane * 8) = oa; *(u32x4*)(hn + tok * DM + 512 + lane * 8) = ob;
  }
}
DEV void resid_gemm(const Params& P, int m0, const bf16_t* A, const bf16_t* Wt, const float* base) {
  GEO
#pragma nounroll
  for (int nt = 0; nt < 4; ++nt) {
    f32x16 acc[2][2]; acc_zero(acc);
    gemm_kloop(acc, A + (size_t)m0 * DM, DM, Wt + (size_t)nt * 256 * DM, DM, DM);
    FOR_ACC {
      const int tok = m0 + 64 * wm + 32 * mb + l32, col = nt * 256 + 64 * wn + 32 * nb + 8 * rq + 4 * hi;
      f32x4 v = *(const f32x4*)(base + (size_t)tok * DM + col);
#pragma unroll
      for (int e = 0; e < 4; ++e) v[e] += acc[nb][mb][4 * rq + e];
      *(f32x4*)(P.out + (size_t)tok * DM + col) = v;
    }
  }
}
DEV void chain_peer_ple(const Params& P, int l, int p) {
  GEO
  const int m0 = p * 128;
  bf16_t* hn = (bf16_t*)(P.ws + WS_HN);
  unsigned char* slice = P.ws + WS_Z + (size_t)p * SLICE;
  float* scoresT = (float*)slice; int* idxs = (int*)(slice + 512 * 1024); float* gs = (float*)(slice + 576 * 1024);
  __syncthreads();
  panel_rmsnorm(P.out, P.norm_ffn + l * DM, hn, m0);
  const bf16_t* wpt = (const bf16_t*)(P.ws + W_PT) + (size_t)l * 2048 * 1024;
#pragma nounroll
  for (int hg = 0; hg < 2; ++hg) {
#pragma nounroll
  for (int nt = 0; nt < 4; ++nt) {
      f32x16 acc[2][2]; acc_zero(acc);
      gemm_kloop(acc, hn + (size_t)m0 * DM, DM, wpt + (size_t)((hg * 4 + nt) * 256) * DM, DM, DM);
      FOR_ACC {
        const int tr = 64 * wm + 32 * mb + l32, col = nt * 256 + 64 * wn + 32 * nb + 8 * rq + 4 * hi;
#pragma unroll
        for (int e = 0; e < 4; ++e) scoresT[(size_t)(col + e) * 128 + tr] = acc[nb][mb][4 * rq + e];
      }
    }
    __syncthreads();
    topk_group(hg, scoresT, idxs, gs);
    __syncthreads();
  }
  peer_gather(P, l, m0, idxs, gs);
  __syncthreads();
  const bf16_t* wg = (const bf16_t*)(P.ws + W_GATE) + (size_t)l * 1024 * 1024;
  const bf16_t* wu = (const bf16_t*)(P.ws + W_UP) + (size_t)l * 1024 * 256;
  const bf16_t* pb = (const bf16_t*)(P.ws + WS_PB) + ((size_t)l * T_TOK + m0) * 256;
#pragma nounroll
  for (int nt = 0; nt < 4; ++nt) {
    unsigned sg[2][2][8];
    {
      f32x16 ag[2][2]; acc_zero(ag);
      gemm_kloop(ag, hn + (size_t)m0 * DM, DM, wg + (size_t)nt * 256 * DM, DM, DM);
#pragma unroll
      for (int nb = 0; nb < 2; ++nb)
#pragma unroll
        for (int mb = 0; mb < 2; ++mb)
#pragma unroll
          for (int q = 0; q < 8; ++q) sg[nb][mb][q] = pk2(sigmoidf_(ag[nb][mb][2 * q]), sigmoidf_(ag[nb][mb][2 * q + 1]));
    }
    f32x16 au[2][2]; acc_zero(au);
    gemm_kloop(au, pb, 256, wu + (size_t)nt * 256 * 256, 256, 256);
    FOR_ACC {
      const int tok = m0 + 64 * wm + 32 * mb + l32, col = nt * 256 + 64 * wn + 32 * nb + 8 * rq + 4 * hi;
      f32x4 v = *(const f32x4*)(P.out + (size_t)tok * DM + col);
      v[0] += au[nb][mb][4 * rq + 0] * bflo(sg[nb][mb][2 * rq]); v[1] += au[nb][mb][4 * rq + 1] * bfhi(sg[nb][mb][2 * rq]);
      v[2] += au[nb][mb][4 * rq + 2] * bflo(sg[nb][mb][2 * rq + 1]); v[3] += au[nb][mb][4 * rq + 3] * bfhi(sg[nb][mb][2 * rq + 1]);
      *(f32x4*)(P.out + (size_t)tok * DM + col) = v;
    }
  }
  __syncthreads();
}

DEV void l1_inproj(const Params& P, int p) {
  GEO
  const int m0 = p * 128;
  bf16_t* hn = (bf16_t*)(P.ws + WS_HN);
  bf16_t* zz = (bf16_t*)(P.ws + WS_Z + (size_t)p * SLICE);
  panel_rmsnorm(P.out, P.norm_mix + DM, hn, m0);
  const bf16_t* wt = (const bf16_t*)(P.ws + W_IN1);
#pragma nounroll
  for (int nt = 0; nt < 8; ++nt) {
    f32x16 acc[2][2]; acc_zero(acc);
    gemm_kloop(acc, hn + (size_t)m0 * DM, DM, wt + (size_t)nt * 256 * DM, DM, DM);
    FOR_ACC {
      const int tr = 64 * wm + 32 * mb + l32, col = nt * 256 + 64 * wn + 32 * nb + 8 * rq + 4 * hi;
      u32x2 o; o[0] = pk2(acc[nb][mb][4 * rq], acc[nb][mb][4 * rq + 1]); o[1] = pk2(acc[nb][mb][4 * rq + 2], acc[nb][mb][4 * rq + 3]);
      *(u32x2*)(zz + (size_t)tr * 2048 + col) = o;
    }
  }
}
DEV void p4_panel(const Params& P, int p) {
  GEO
  const int m0 = p * 128, s0 = m0 % SEQ;
  bf16_t* xrc = (bf16_t*)(P.ws + WS_HN);
  const bf16_t* zz = (const bf16_t*)(P.ws + WS_Z + (size_t)p * SLICE);
  const bf16_t* zzp = (const bf16_t*)(P.ws + WS_Z + (size_t)(p - 1) * SLICE);
  bf16_t* la = (bf16_t*)(P.ws + WS_TAB);
  bf16_t* ub = (bf16_t*)(P.ws + WS_Z + (size_t)p * SLICE + 512 * 1024);
  __syncthreads();
#pragma unroll
  for (int q = 0; q < 2; ++q) {
    const int ch = tid + q * 512;
    const float w0 = P.odd_conv_w[ch], w1 = P.odd_conv_w[1024 + ch], w2 = P.odd_conv_w[2048 + ch], w3 = P.odd_conv_w[3072 + ch], cb = P.odd_conv_b[ch];
    float x3 = 0.f, x2 = 0.f, x1 = 0.f;
    if (s0 > 0) { x3 = bf2f(zzp[(size_t)125 * 2048 + 1024 + ch]); x2 = bf2f(zzp[(size_t)126 * 2048 + 1024 + ch]); x1 = bf2f(zzp[(size_t)127 * 2048 + 1024 + ch]); }
    for (int t = 0; t < 128; ++t) {
      const float x0 = bf2f(zz[(size_t)t * 2048 + 1024 + ch]);
      xrc[(size_t)(m0 + t) * DM + ch] = f2bf(w0 * x3 + w1 * x2 + w2 * x1 + w3 * x0 + cb);
      x3 = x2; x2 = x1; x1 = x0;
    }
  }
  __syncthreads();
  const bf16_t* wax = (const bf16_t*)(P.ws + W_AX);
#pragma nounroll
  for (int h = 0; h < 8; ++h) {
    f32x16 acc[2][2]; acc_zero(acc);
    gemm_kloop(acc, xrc + (size_t)m0 * DM + h * 128, DM, wax + (size_t)h * 256 * 128, 128, 128);
#pragma unroll
    for (int rq = 0; rq < 4; ++rq) {
      const int ch = h * 128 + 32 * wn + 8 * rq + 4 * hi;
      const f32x4 ba = *(const f32x4*)(P.odd_b_a + ch), bx = *(const f32x4*)(P.odd_b_x + ch), lp = *(const f32x4*)(P.odd_lru + ch);
      float sp[4];
#pragma unroll
      for (int e = 0; e < 4; ++e) { const float nl = -lp[e]; sp[e] = fmaxf(nl, 0.f) + log1pf(__expf(-fabsf(nl))); }
#pragma unroll
      for (int mb = 0; mb < 2; ++mb) {
        const int tr = 64 * wm + 32 * mb + l32; const size_t tok = (size_t)(m0 + tr);
        const u32x2 xr = *(const u32x2*)(xrc + tok * DM + ch);
        const float xv[4] = {bflo(xr[0]), bfhi(xr[0]), bflo(xr[1]), bfhi(xr[1])};
        float lav[4], uv[4];
#pragma unroll
        for (int e = 0; e < 4; ++e) {
          const float rg = sigmoidf_(acc[0][mb][4 * rq + e] + ba[e]), ig = sigmoidf_(acc[1][mb][4 * rq + e] + bx[e]);
          lav[e] = -8.f * rg * sp[e];
          uv[e] = sqrtf(-expm1f(2.f * lav[e])) * (ig * xv[e]);
        }
        u32x2 o1, o2; o1[0] = pk2(lav[0], lav[1]); o1[1] = pk2(lav[2], lav[3]); o2[0] = pk2(uv[0], uv[1]); o2[1] = pk2(uv[2], uv[3]);
        *(u32x2*)(la + tok * DM + ch) = o1;
        *(u32x2*)(ub + (size_t)tr * DM + ch) = o2;
      }
    }
  }
  __syncthreads();
  float* aprod = (float*)(P.ws + WS_APROD); float* hend = (float*)(P.ws + WS_HEND);
#pragma unroll
  for (int q = 0; q < 2; ++q) {
    const int ch = tid + q * 512;
    float Asum = 0.f, H = 0.f;
    for (int t = 0; t < 128; ++t) {
      const float lv = bf2f(la[(size_t)(m0 + t) * DM + ch]), u = bf2f(ub[(size_t)t * DM + ch]);
      H = __expf(lv) * H + u; Asum += lv;
    }
    aprod[p * DM + ch] = __expf(Asum); hend[p * DM + ch] = H;
  }
}
DEV void p5_pre(const Params& P, int p) {
  GEO
  const int m0 = p * 128;
  const int pfirst = (p >> 7) << 7;
  const float* aprod = (const float*)(P.ws + WS_APROD); const float* hend = (const float*)(P.ws + WS_HEND);
  const bf16_t* la = (const bf16_t*)(P.ws + WS_TAB);
  const bf16_t* ub = (const bf16_t*)(P.ws + WS_Z + (size_t)p * SLICE + 512 * 1024);
  const bf16_t* zz = (const bf16_t*)(P.ws + WS_Z + (size_t)p * SLICE);
  bf16_t* y = (bf16_t*)(P.ws + WS_HN);
  __syncthreads();
#pragma unroll
  for (int q = 0; q < 2; ++q) {
    const int ch = tid + q * 512;
    float H = 0.f;
#pragma unroll 8
    for (int pp = pfirst; pp < p; ++pp) H = aprod[pp * DM + ch] * H + hend[pp * DM + ch];
    for (int t = 0; t < 128; ++t) {
      const float lv = bf2f(la[(size_t)(m0 + t) * DM + ch]), u = bf2f(ub[(size_t)t * DM + ch]);
      H = __expf(lv) * H + u;
      const float gt_ = bf2f(zz[(size_t)t * 2048 + ch]);
      y[(size_t)(m0 + t) * DM + ch] = f2bf(H * gelu_tanh(gt_));
    }
  }
  __syncthreads();
}

__global__ void __launch_bounds__(512) mega(Params P) {
  cg::grid_group grid = cg::this_grid();
  const int tid = threadIdx.x;
  unsigned char* ws = P.ws;
  transpose_job(P.even_w_in, 1024, 3072, 3080, (bf16_t*)(ws + W_IN0), 1024);
  transpose_job(P.even_w_out, 1024, 1024, 1024, (bf16_t*)(ws + W_OUT0), 1024);
  transpose_job(P.odd_w_in, 1024, 2048, 2048, (bf16_t*)(ws + W_IN1), 1024);
  transpose_job(P.odd_w_out, 1024, 1024, 1024, (bf16_t*)(ws + W_OUT1), 1024);
#pragma nounroll
  for (int l = 0; l < 2; ++l) {
    transpose_job(P.ple_up + (size_t)l * 256 * 1024, 256, 1024, 1024, (bf16_t*)(ws + W_UP) + (size_t)l * 1024 * 256, 256);
    transpose_job(P.ple_gate + (size_t)l * 1024 * 1024, 1024, 1024, 1024, (bf16_t*)(ws + W_GATE) + (size_t)l * 1024 * 1024, 1024);
  }
  convert_job(P.peer_wq, (bf16_t*)(ws + W_QB), (size_t)2 * 1024 * 2048);
  convert_job(P.p, (bf16_t*)(ws + WS_PB), (size_t)2 * T_TOK * 256);
#pragma nounroll
  for (int l = 0; l < 2; ++l) {
    convert_job(P.peer_u + (size_t)l * 16384 * 1024, (bf16_t*)(ws + WS_TAB) + (size_t)(2 * l) * 16384 * 1024, (size_t)16384 * 1024);
    convert_job(P.peer_v + (size_t)l * 16384 * 1024, (bf16_t*)(ws + WS_TAB) + (size_t)(2 * l + 1) * 16384 * 1024, (size_t)16384 * 1024);
  }
  {
    const int gsz = gridDim.x * 512, gid = blockIdx.x * 512 + tid;
    bf16_t* bsk = (bf16_t*)(ws + W_SK);
    for (int i = gid; i < 2 * 65536; i += gsz) {
      const int l = i >> 16, n = (i >> 8) & 255, k = i & 255;
      float v = 0.f;
      if ((n < 128) == (k < 128)) v = P.peer_sk[(size_t)l * 32768 + (size_t)(n >> 7) * 16384 + (n & 127) * 128 + (k & 127)];
      bsk[i] = f2bf(v);
    }
    bf16_t* wax = (bf16_t*)(ws + W_AX);
    for (int i = gid; i < 8 * 256 * 128; i += gsz) {
      const int h = i >> 15, n = (i >> 7) & 255, k = i & 127;
      const int wn = n >> 6, nb = (n >> 5) & 1, jj = n & 31;
      const float* src = nb ? P.odd_w_x : P.odd_w_a;
      wax[i] = f2bf(src[(size_t)h * 16384 + k * 128 + 32 * wn + jj]);
    }
  }
  grid.sync();
#pragma nounroll
  for (int p = blockIdx.x; p < NPANEL; p += gridDim.x) { asm volatile("" ::: "memory"); p1_panel(P, p); }
#pragma nounroll
  for (int u = blockIdx.x; u < 128; u += gridDim.x) { asm volatile("" ::: "memory"); fold_unit(P, u); }
  grid.sync();
#pragma nounroll
  for (int blk = blockIdx.x; blk < 256; blk += gridDim.x) {
    asm volatile("" ::: "memory");
    const int bh = blk & 7, s = blk >> 3, b = bh >> 2, hp = bh & 3;
    attn_unit(P, b, 127 - s, hp);
    attn_unit(P, b, 64 + s, hp);
    attn_unit(P, b, 63 - s, hp);
    attn_unit(P, b, s, hp);
  }
#pragma nounroll
  for (int p = blockIdx.x; p < NPANEL; p += gridDim.x) { asm volatile("" ::: "memory"); conv_mixer(P, p); }
  grid.sync();
#pragma nounroll
  for (int p = blockIdx.x; p < NPANEL; p += gridDim.x) {
    asm volatile("" ::: "memory");
    resid_gemm(P, p * 128, (const bf16_t*)(ws + WS_HN), (const bf16_t*)(ws + W_OUT0), P.x);
    chain_peer_ple(P, 0, p);
    l1_inproj(P, p);
  }
  grid.sync();
#pragma nounroll
  for (int p = blockIdx.x; p < NPANEL; p += gridDim.x) { asm volatile("" ::: "memory"); p4_panel(P, p); }
  grid.sync();
#pragma nounroll
  for (int p = blockIdx.x; p < NPANEL; p += gridDim.x) {
    asm volatile("" ::: "memory");
    p5_pre(P, p);
    resid_gemm(P, p * 128, (const bf16_t*)(ws + WS_HN), (const bf16_t*)(ws + W_OUT1), P.out);
    chain_peer_ple(P, 1, p);
  }
}

extern "C" void kernel_launch(void* const* d_in, const int* in_sizes, int n_in, void* d_out, int out_size, void* d_ws, size_t ws_size, hipStream_t stream) {
  static int grid_blocks = 0;
  if (grid_blocks == 0) {
    if (n_in != 26 || ws_size < WS_END) { fprintf(stderr, "kernel_launch: unexpected n_in %d / ws_size %zu\n", n_in, ws_size); grid_blocks = -1; return; }
    int dev = 0, cus = 0, per_cu = 0;
    hipGetDevice(&dev);
    hipDeviceGetAttribute(&cus, hipDeviceAttributeMultiprocessorCount, dev);
    hipFuncSetAttribute((const void*)mega, hipFuncAttributeMaxDynamicSharedMemorySize, LDS_BYTES);
    hipOccupancyMaxActiveBlocksPerMultiprocessor(&per_cu, (const void*)mega, 512, LDS_BYTES);
    if (per_cu < 1) { fprintf(stderr, "kernel_launch: occupancy query reports 0 blocks per CU\n"); grid_blocks = -1; return; }
    grid_blocks = cus;
    if (grid_blocks > 256) grid_blocks = 256;
  }
  if (grid_blocks < 0) return;
  Params P{};
  const float** pp = (const float**)&P;
  for (int i = 0; i < 26; ++i) pp[i] = (const float*)d_in[i];
  P.out = (float*)d_out; P.ws = (unsigned char*)d_ws;
  void* args[] = {&P};
  hipError_t e = hipLaunchCooperativeKernel((const void*)mega, dim3(grid_blocks), dim3(512), args, LDS_BYTES, stream);
  if (e != hipSuccess) fprintf(stderr, "cooperative launch failed: %s (grid %d)\n", hipGetErrorString(e), grid_blocks);
}
```

```cpp
#include <hip/hip_runtime.h>
#include <hip/hip_cooperative_groups.h>
#include <stdint.h>
#include <cstdio>
namespace cg = cooperative_groups;

typedef unsigned short bf16_t;
typedef short bf16x8 __attribute__((ext_vector_type(8)));
typedef float f32x16 __attribute__((ext_vector_type(16)));
typedef float f32x4 __attribute__((ext_vector_type(4)));
typedef unsigned u32x4 __attribute__((ext_vector_type(4)));
typedef unsigned u32x2 __attribute__((ext_vector_type(2)));
typedef float f32x2_t __attribute__((ext_vector_type(2)));
typedef __bf16 bf16x2_t __attribute__((ext_vector_type(2)));
#define DEV __device__ __forceinline__

constexpr int T_TOK = 32768, SEQ = 16384, DM = 1024, NPANEL = 256;
constexpr float EPS = 1e-6f, LOG2E = 1.4426950408889634f;
constexpr size_t MB = 1u << 20;
constexpr size_t WS_FLOC = 0;
constexpr size_t WS_PTOT = 1 * MB;
constexpr size_t WS_APROD = 2 * MB;
constexpr size_t WS_HEND = 3 * MB;
constexpr size_t WS_W = 4 * MB;
constexpr size_t W_IN0 = WS_W, W_OUT0 = WS_W + 6 * MB, W_IN1 = WS_W + 8 * MB, W_AX = WS_W + 12 * MB, W_OUT1 = WS_W + 13 * MB,
                 W_QB = WS_W + 15 * MB, W_SK = WS_W + 23 * MB, W_PT = WS_W + 24 * MB, W_UP = WS_W + 32 * MB, W_GATE = WS_W + 33 * MB;
constexpr size_t WS_TAB = 44 * MB;
constexpr size_t WS_PB = 172 * MB;
constexpr size_t WS_HN = 204 * MB;
constexpr size_t WS_Z = 268 * MB;
constexpr size_t WS_VT = 460 * MB;
constexpr size_t WS_END = 492 * MB;
constexpr size_t SLICE = 768 * 1024;

constexpr int LDS_BYTES = 131072;
constexpr int LROW = 144;
constexpr int G_B = 128 * LROW, G_STAGE = 384 * LROW;
constexpr int LDS_MISC = 2 * G_STAGE;

extern __shared__ __attribute__((aligned(16))) unsigned char smem[];

struct Params {
  const float *x, *p, *norm_mix, *norm_ffn, *norm_ple, *even_w_in, *even_b_forget, *even_conv_w, *even_q_gain, *even_k_gain, *even_w_out,
      *odd_w_in, *odd_conv_w, *odd_conv_b, *odd_w_a, *odd_b_a, *odd_w_x, *odd_b_x, *odd_lru, *odd_w_out,
      *peer_wq, *peer_sk, *peer_u, *peer_v, *ple_up, *ple_gate;
  float* out; unsigned char* ws;
};

DEV unsigned pk2(float lo, float hi) { f32x2_t v = {lo, hi}; bf16x2_t b = __builtin_convertvector(v, bf16x2_t); return __builtin_bit_cast(unsigned, b); }
DEV float bflo(unsigned u) { return __uint_as_float(u << 16); }
DEV float bfhi(unsigned u) { return __uint_as_float(u & 0xffff0000u); }
DEV float bf2f(bf16_t v) { return __uint_as_float((unsigned)v << 16); }
DEV bf16_t f2bf(float f) { return (bf16_t)(pk2(f, 0.f) & 0xffffu); }
DEV int tid_l() { int t = threadIdx.x; asm volatile("" : "+v"(t)); return t; }
DEV float wave_sum(float v) {
#pragma unroll
  for (int o = 1; o < 64; o <<= 1) v += __shfl_xor(v, o);
  return v;
}
DEV float gelu_tanh(float x) { const float u = 1.5957691216057308f * (x + 0.044715f * x * x * x); return x / (1.f + __expf(-u)); }
DEV float sigmoidf_(float x) { return 1.f / (1.f + __expf(-x)); }

DEV void gemm_kloop(f32x16 (&acc)[2][2], const bf16_t* A, int lda, const bf16_t* Bt, int ldb, int K) {
  const int tid = tid_l(), lane = tid & 63, wid = tid >> 6, wm = wid & 1, wn = wid >> 1, l32 = lane & 31, hi = lane >> 5;
  const int c = tid & 7, r = tid >> 3;
  const bf16_t* ga = A + (size_t)r * lda + c * 8;
  const bf16_t* gb = Bt + (size_t)r * ldb + c * 8;
  const int sa = r * LROW + c * 16, sb = G_B + r * LROW + c * 16;
  const int xa = (64 * wm + l32) * LROW + hi * 16, wb = G_B + (64 * wn + l32) * LROW + hi * 16;
  u32x4 ra[2], rb[4];
  const int nk = K >> 6;
  __syncthreads();
#pragma unroll
  for (int i = 0; i < 2; ++i) ra[i] = *(const u32x4*)(ga + (size_t)i * 64 * lda);
#pragma unroll
  for (int i = 0; i < 4; ++i) rb[i] = *(const u32x4*)(gb + (size_t)i * 64 * ldb);
#pragma unroll
  for (int i = 0; i < 2; ++i) *(u32x4*)(smem + sa + i * 64 * LROW) = ra[i];
#pragma unroll
  for (int i = 0; i < 4; ++i) *(u32x4*)(smem + sb + i * 64 * LROW) = rb[i];
  __syncthreads();
#pragma nounroll
  for (int kt = 0; kt < nk; ++kt) {
    const int st = (kt & 1) * G_STAGE;
    const bool more = kt + 1 < nk;
    if (more) {
      ga += 64; gb += 64;
#pragma unroll
      for (int i = 0; i < 2; ++i) ra[i] = *(const u32x4*)(ga + (size_t)i * 64 * lda);
#pragma unroll
      for (int i = 0; i < 4; ++i) rb[i] = *(const u32x4*)(gb + (size_t)i * 64 * ldb);
    }
#pragma unroll
    for (int ks = 0; ks < 4; ++ks) {
      bf16x8 xf[2], wf[2];
#pragma unroll
      for (int mb = 0; mb < 2; ++mb) xf[mb] = *(const bf16x8*)(smem + st + xa + mb * 32 * LROW + ks * 32);
#pragma unroll
      for (int nb = 0; nb < 2; ++nb) wf[nb] = *(const bf16x8*)(smem + st + wb + nb * 32 * LROW + ks * 32);
#pragma unroll
      for (int nb = 0; nb < 2; ++nb)
#pragma unroll
        for (int mb = 0; mb < 2; ++mb) acc[nb][mb] = __builtin_amdgcn_mfma_f32_32x32x16_bf16(wf[nb], xf[mb], acc[nb][mb], 0, 0, 0);
    }
    if (more) {
      const int so = st ^ G_STAGE;
#pragma unroll
      for (int i = 0; i < 2; ++i) *(u32x4*)(smem + so + sa + i * 64 * LROW) = ra[i];
#pragma unroll
      for (int i = 0; i < 4; ++i) *(u32x4*)(smem + so + sb + i * 64 * LROW) = rb[i];
    }
    __syncthreads();
  }
}
DEV void acc_zero(f32x16 (&acc)[2][2]) {
#pragma unroll
  for (int a = 0; a < 2; ++a)
#pragma unroll
    for (int b = 0; b < 2; ++b)
#pragma unroll
      for (int r = 0; r < 16; ++r) acc[a][b][r] = 0.f;
}
#define GEO const int tid = tid_l(), lane = tid & 63, wid = tid >> 6, wm = wid & 1, wn = wid >> 1, l32 = lane & 31, hi = lane >> 5; (void)wm; (void)wn; (void)l32; (void)hi; (void)lane; (void)wid;
#define FOR_ACC _Pragma("unroll") for (int nb = 0; nb < 2; ++nb) _Pragma("unroll") for (int mb = 0; mb < 2; ++mb) _Pragma("unroll") for (int rq = 0; rq < 4; ++rq)

DEV void transpose_job(const float* __restrict__ W, int K, int N, int ldw, bf16_t* Wt, int ldt) {
  float* tile = (float*)smem;
  const int tid = tid_l(); const int ntn = N >> 6, ntiles = (K >> 6) * ntn;
  for (int t = blockIdx.x; t < ntiles; t += gridDim.x) {
    const int k0 = (t / ntn) << 6, n0 = (t % ntn) << 6;
    __syncthreads();
#pragma unroll
    for (int q = 0; q < 2; ++q) {
      const int id = tid + q * 512, i = id >> 4, c4 = (id & 15) << 2;
      const f32x4 v = *(const f32x4*)(W + (size_t)(k0 + i) * ldw + n0 + c4);
      tile[i * 65 + c4 + 0] = v[0]; tile[i * 65 + c4 + 1] = v[1]; tile[i * 65 + c4 + 2] = v[2]; tile[i * 65 + c4 + 3] = v[3];
    }
    __syncthreads();
    const int n = tid >> 3, kc = (tid & 7) << 3;
    u32x4 o;
    o[0] = pk2(tile[(kc + 0) * 65 + n], tile[(kc + 1) * 65 + n]); o[1] = pk2(tile[(kc + 2) * 65 + n], tile[(kc + 3) * 65 + n]);
    o[2] = pk2(tile[(kc + 4) * 65 + n], tile[(kc + 5) * 65 + n]); o[3] = pk2(tile[(kc + 6) * 65 + n], tile[(kc + 7) * 65 + n]);
    *(u32x4*)(Wt + (size_t)(n0 + n) * ldt + k0 + kc) = o;
  }
  __syncthreads();
}
DEV void convert_job(const float* __restrict__ src, bf16_t* dst, size_t n) {
  const size_t stride = (size_t)gridDim.x * 512 * 8;
  for (size_t i = ((size_t)blockIdx.x * 512 + threadIdx.x) * 8; i < n; i += stride) {
    const f32x4 a = *(const f32x4*)(src + i), b = *(const f32x4*)(src + i + 4);
    u32x4 o; o[0] = pk2(a[0], a[1]); o[1] = pk2(a[2], a[3]); o[2] = pk2(b[0], b[1]); o[3] = pk2(b[2], b[3]);
    *(u32x4*)(dst + i) = o;
  }
}

DEV void convert_fp8_job(const float* __restrict__ src, unsigned char* dst, size_t n) {
  const size_t stride = (size_t)gridDim.x * 512 * 16;
  for (size_t i = ((size_t)blockIdx.x * 512 + threadIdx.x) * 16; i < n; i += stride) {
    u32x4 o;
#pragma unroll
    for (int q = 0; q < 4; ++q) {
      const f32x4 a = *(const f32x4*)(src + i + 4 * q);
      int d = __builtin_amdgcn_cvt_pk_fp8_f32(a[0] * 64.f, a[1] * 64.f, 0, false);
      d = __builtin_amdgcn_cvt_pk_fp8_f32(a[2] * 64.f, a[3] * 64.f, d, true);
      o[q] = (unsigned)d;
    }
    *(u32x4*)(dst + i) = o;
  }
}
DEV void panel_rmsnorm(const float* src, const float* __restrict__ gain, bf16_t* dst, int m0) {
  GEO
  f32x4 g[4];
#pragma unroll
  for (int j = 0; j < 4; ++j) g[j] = *(const f32x4*)(gain + j * 256 + lane * 4);
#pragma nounroll
  for (int i = 0; i < 16; ++i) {
    const size_t row = (size_t)(m0 + wid * 16 + i) * DM;
    f32x4 v[4]; float s = 0.f;
#pragma unroll
    for (int j = 0; j < 4; ++j) { v[j] = *(const f32x4*)(src + row + j * 256 + lane * 4); s += v[j][0] * v[j][0] + v[j][1] * v[j][1] + v[j][2] * v[j][2] + v[j][3] * v[j][3]; }
    const float rstd = rsqrtf(wave_sum(s) * (1.f / DM) + EPS);
#pragma unroll
    for (int j = 0; j < 4; ++j) {
      u32x2 o; o[0] = pk2(v[j][0] * rstd * g[j][0], v[j][1] * rstd * g[j][1]); o[1] = pk2(v[j][2] * rstd * g[j][2], v[j][3] * rstd * g[j][3]);
      *(u32x2*)(dst + row + j * 256 + lane * 4) = o;
    }
  }
}

DEV void p1_panel(const Params& P, int p) {
  GEO
  const int m0 = p * 128;
  bf16_t* hn = (bf16_t*)(P.ws + WS_HN);
  bf16_t* z = (bf16_t*)(P.ws + WS_Z);
  bf16_t* vt = (bf16_t*)(P.ws + WS_VT);
  float* floc = (float*)(P.ws + WS_FLOC);
  float* ptot = (float*)(P.ws + WS_PTOT);
  float* lf = (float*)(smem + LDS_MISC);
  {
    float wfr[4][4][8]; f32x4 g[4];
#pragma unroll
    for (int j = 0; j < 4; ++j) {
      g[j] = *(const f32x4*)(P.norm_mix + j * 256 + lane * 4);
#pragma unroll
      for (int e = 0; e < 4; ++e) {
        const float* wp = P.even_w_in + (size_t)(j * 256 + lane * 4 + e) * 3080 + 3072;
        const f32x4 a = *(const f32x4*)wp, b = *(const f32x4*)(wp + 4);
        wfr[j][e][0] = a[0]; wfr[j][e][1] = a[1]; wfr[j][e][2] = a[2]; wfr[j][e][3] = a[3];
        wfr[j][e][4] = b[0]; wfr[j][e][5] = b[1]; wfr[j][e][6] = b[2]; wfr[j][e][7] = b[3];
      }
    }
  #pragma nounroll
  for (int i = 0; i < 16; ++i) {
      const size_t row = (size_t)(m0 + wid * 16 + i) * DM;
      f32x4 v[4]; float s = 0.f;
#pragma unroll
      for (int j = 0; j < 4; ++j) { v[j] = *(const f32x4*)(P.x + row + j * 256 + lane * 4); s += v[j][0] * v[j][0] + v[j][1] * v[j][1] + v[j][2] * v[j][2] + v[j][3] * v[j][3]; }
      const float rstd = rsqrtf(wave_sum(s) * (1.f / DM) + EPS);
      float fs[8];
#pragma unroll
      for (int h = 0; h < 8; ++h) fs[h] = 0.f;
#pragma unroll
      for (int j = 0; j < 4; ++j) {
        float hv[4];
#pragma unroll
        for (int e = 0; e < 4; ++e) {
          hv[e] = v[j][e] * rstd * g[j][e];
#pragma unroll
          for (int h = 0; h < 8; ++h) fs[h] += hv[e] * wfr[j][e][h];
        }
        u32x2 o; o[0] = pk2(hv[0], hv[1]); o[1] = pk2(hv[2], hv[3]);
        *(u32x2*)(hn + row + j * 256 + lane * 4) = o;
      }
#pragma unroll
      for (int h = 0; h < 8; ++h) fs[h] = wave_sum(fs[h]);
      if (lane < 8) {
        float f = fs[0];
#pragma unroll
        for (int h = 1; h < 8; ++h) f = (lane == h) ? fs[h] : f;
        const float xx = f + P.even_b_forget[lane];
        lf[(wid * 16 + i) * 8 + lane] = fminf(xx, 0.f) - log1pf(__expf(-fabsf(xx)));
      }
    }
  }
  __syncthreads();
  if (tid < 8) {
    const int b = m0 / SEQ, s0 = m0 % SEQ;
    float cum = 0.f; float* fo = floc + (size_t)(b * 8 + tid) * SEQ + s0;
    for (int t = 0; t < 128; ++t) { cum += lf[t * 8 + tid]; fo[t] = cum; }
    ptot[p * 8 + tid] = cum;
  }
  const bf16_t* wt = (const bf16_t*)(P.ws + W_IN0);
#pragma nounroll
  for (int nt = 0; nt < 12; ++nt) {
    f32x16 acc[2][2]; acc_zero(acc);
    gemm_kloop(acc, hn + (size_t)m0 * DM, DM, wt + (size_t)nt * 256 * DM, DM, DM);
    const int n0 = nt * 256;
    if (nt < 6) {
      FOR_ACC {
        const int tok = m0 + 64 * wm + 32 * mb + l32, col = n0 + 64 * wn + 32 * nb + 8 * rq + 4 * hi;
        u32x2 o; o[0] = pk2(acc[nb][mb][4 * rq], acc[nb][mb][4 * rq + 1]); o[1] = pk2(acc[nb][mb][4 * rq + 2], acc[nb][mb][4 * rq + 3]);
        *(u32x2*)(z + (size_t)tok * 3072 + col) = o;
      }
    } else if (nt < 10) {
      const bool isq = nt < 8;
      const float* gn = isq ? P.even_q_gain : P.even_k_gain;
      const float extra = isq ? 0.125f * LOG2E : 1.f;
#pragma unroll
      for (int mb = 0; mb < 2; ++mb) {
        float s = 0.f;
#pragma unroll
        for (int nb = 0; nb < 2; ++nb)
#pragma unroll
          for (int r = 0; r < 16; ++r) s += acc[nb][mb][r] * acc[nb][mb][r];
        s += __shfl_xor(s, 32);
        const float rstd = rsqrtf(s * (1.f / 64.f) + EPS) * extra;
        const int tok = m0 + 64 * wm + 32 * mb + l32;
#pragma unroll
        for (int nb = 0; nb < 2; ++nb)
#pragma unroll
          for (int rq = 0; rq < 4; ++rq) {
            const int cl = 32 * nb + 8 * rq + 4 * hi;
            const f32x4 gg = *(const f32x4*)(gn + cl);
            u32x2 o; o[0] = pk2(acc[nb][mb][4 * rq] * rstd * gg[0], acc[nb][mb][4 * rq + 1] * rstd * gg[1]);
            o[1] = pk2(acc[nb][mb][4 * rq + 2] * rstd * gg[2], acc[nb][mb][4 * rq + 3] * rstd * gg[3]);
            *(u32x2*)(z + (size_t)tok * 3072 + n0 + 64 * wn + cl) = o;
          }
      }
    } else {
      FOR_ACC {
        const int tok = m0 + 64 * wm + 32 * mb + l32, col = n0 + 64 * wn + 32 * nb + 8 * rq + 4 * hi - 2560;
        const int b = tok / SEQ, s = tok % SEQ;
#pragma unroll
        for (int e = 0; e < 4; ++e) vt[(size_t)(b * 512 + col + e) * SEQ + s] = f2bf(acc[nb][mb][4 * rq + e]);
      }
    }
  }
}
DEV void fold_unit(const Params& P, int u) {
  GEO
  const int l = u >> 6, jt = (u >> 3) & 7, hh = u & 7;
  const bf16_t* A = (const bf16_t*)(P.ws + W_QB) + (size_t)l * 1024 * 2048 + (size_t)(jt * 128) * 2048 + hh * 256;
  const bf16_t* Bt = (const bf16_t*)(P.ws + W_SK) + (size_t)l * 65536;
  bf16_t* wpt = (bf16_t*)(P.ws + W_PT);
  f32x16 acc[2][2]; acc_zero(acc);
  gemm_kloop(acc, A, 2048, Bt, 256, 256);
  FOR_ACC {
    const int j = jt * 128 + 64 * wm + 32 * mb + l32, n = 64 * wn + 32 * nb + 8 * rq + 4 * hi;
#pragma unroll
    for (int e = 0; e < 4; ++e) wpt[((size_t)l * 2048 + hh * 256 + n + e) * 1024 + j] = f2bf(acc[nb][mb][4 * rq + e]);
  }
}

constexpr int AT_K = 0, AT_V = 64 * LROW, AT_BIAS = 128 * LROW, AT_STG = 128 * LROW + 256;
constexpr int AT_GRP = 2 * AT_STG;
constexpr int AT_SUF = 2 * AT_GRP;
DEV int crow(int r, int hi) { return 8 * (r >> 2) + 4 * hi + (r & 3); }

DEV void attn_unit(const Params& P, int b, int qb, int hp) {
  const int tid = tid_l(), lane = tid & 63, wid = tid >> 6, l32 = lane & 31, hi = lane >> 5;
  const int g = wid >> 2, wq = wid & 3, h = 2 * hp + g, gt = tid & 255;
  const bf16_t* z = (const bf16_t*)(P.ws + WS_Z);
  const bf16_t* vt = (const bf16_t*)(P.ws + WS_VT);
  bf16_t* ycat = (bf16_t*)(P.ws + WS_HN);
  const float* fl = (const float*)(P.ws + WS_FLOC) + (size_t)(b * 8 + h) * SEQ;
  const float* ptot = (const float*)(P.ws + WS_PTOT);
  float* suf = (float*)(smem + AT_SUF) + g * 128;
  __syncthreads();
  float val = 0.f;
  if (gt < 128) { val = (gt < qb) ? ptot[(b * 128 + gt) * 8 + h] : 0.f; suf[gt] = val; }
#pragma nounroll
  for (int off = 1; off < 128; off <<= 1) {
    __syncthreads();
    float v2 = 0.f;
    if (gt < 128 && gt + off < 128) v2 = suf[gt + off];
    __syncthreads();
    if (gt < 128) { val += v2; suf[gt] = val; }
  }
  __syncthreads();
  const int tokq = b * SEQ + qb * 128 + wq * 32 + l32;
  bf16x8 qf[4];
#pragma unroll
  for (int d0 = 0; d0 < 4; ++d0) qf[d0] = *(const bf16x8*)(z + (size_t)tokq * 3072 + 1536 + h * 64 + d0 * 16 + hi * 8);
  const float fend = fl[qb * 128 + 127];
  const int kc = gt & 7, kr = gt >> 3;
  const bf16_t* kg = z + (size_t)(b * SEQ + kr) * 3072 + 2048 + h * 64 + kc * 8;
  const bf16_t* vg = vt + (size_t)((b * 8 + h) * 64 + kr) * SEQ + kc * 8;
  const int gbase = g * AT_GRP;
  const int sk_ = kr * LROW + kc * 16;
  const int NT = 2 * qb + 2;
  u32x4 rk[2], rv[2]; float rbias = 0.f;
#define AT_LOAD(t) do { \
    rk[0] = *(const u32x4*)(kg + (size_t)(t) * 64 * 3072); rk[1] = *(const u32x4*)(kg + (size_t)((t) * 64 + 32) * 3072); \
    rv[0] = *(const u32x4*)(vg + (t) * 64); rv[1] = *(const u32x4*)(vg + (size_t)32 * SEQ + (t) * 64); \
    if (gt < 64) { const int j_ = (t) * 64 + gt; rbias = (fend - fl[j_] + suf[j_ >> 7]) * LOG2E; } } while (0)
#define AT_STORE(st) do { \
    *(u32x4*)(smem + (st) + AT_K + sk_) = rk[0]; *(u32x4*)(smem + (st) + AT_K + sk_ + 32 * LROW) = rk[1]; \
    *(u32x4*)(smem + (st) + AT_V + sk_) = rv[0]; *(u32x4*)(smem + (st) + AT_V + sk_ + 32 * LROW) = rv[1]; \
    if (gt < 64) *(float*)(smem + (st) + AT_BIAS + gt * 4) = rbias; } while (0)
  AT_LOAD(0);
  AT_STORE(gbase);
  __syncthreads();
  float m = -INFINITY, l = 0.f;
  f32x16 o[2];
#pragma unroll
  for (int r = 0; r < 16; ++r) { o[0][r] = 0.f; o[1][r] = 0.f; }
#pragma nounroll
  for (int t = 0; t < NT; ++t) {
    const int st = gbase + (t & 1) * AT_STG;
    const bool more = t + 1 < NT;
    if (more) AT_LOAD(t + 1);
    const bool active = !(t == 2 * qb + 1 && wq < 2);
    if (active) {
      f32x16 s0, s1;
#pragma unroll
      for (int r = 0; r < 16; ++r) { s0[r] = 0.f; s1[r] = 0.f; }
#pragma unroll
      for (int d0 = 0; d0 < 4; ++d0) {
        const bf16x8 k0 = *(const bf16x8*)(smem + st + AT_K + l32 * LROW + d0 * 32 + hi * 16);
        const bf16x8 k1 = *(const bf16x8*)(smem + st + AT_K + (32 + l32) * LROW + d0 * 32 + hi * 16);
        s0 = __builtin_amdgcn_mfma_f32_32x32x16_bf16(k0, qf[d0], s0, 0, 0, 0);
        s1 = __builtin_amdgcn_mfma_f32_32x32x16_bf16(k1, qf[d0], s1, 0, 0, 0);
      }
#pragma unroll
      for (int rq = 0; rq < 4; ++rq) {
        const f32x4 b0 = *(const f32x4*)(smem + st + AT_BIAS + (8 * rq + 4 * hi) * 4);
        const f32x4 b1 = *(const f32x4*)(smem + st + AT_BIAS + (32 + 8 * rq + 4 * hi) * 4);
#pragma unroll
        for (int e = 0; e < 4; ++e) { s0[4 * rq + e] += b0[e]; s1[4 * rq + e] += b1[e]; }
      }
      if (t >= 2 * qb) {
        const int kb = 64 * (t - 2 * qb), qrel = 32 * wq + l32;
#pragma unroll
        for (int r = 0; r < 16; ++r) {
          const int kv = kb + crow(r, hi);
          if (kv > qrel) s0[r] = -INFINITY;
          if (kv + 32 > qrel) s1[r] = -INFINITY;
        }
      }
      float mx = s0[0];
#pragma unroll
      for (int r = 1; r < 16; ++r) mx = fmaxf(mx, s0[r]);
#pragma unroll
      for (int r = 0; r < 16; ++r) mx = fmaxf(mx, s1[r]);
      mx = fmaxf(mx, __shfl_xor(mx, 32));
      const float mn = fmaxf(m, mx);
      const float alpha = __builtin_amdgcn_exp2f(m - mn);
      m = mn;
      float ls = 0.f;
#pragma unroll
      for (int r = 0; r < 16; ++r) { s0[r] = __builtin_amdgcn_exp2f(s0[r] - mn); s1[r] = __builtin_amdgcn_exp2f(s1[r] - mn); ls += s0[r] + s1[r]; }
      l = l * alpha + ls;
#pragma unroll
      for (int r = 0; r < 16; ++r) { o[0][r] *= alpha; o[1][r] *= alpha; }
      bf16x8 pf[2][2];
#pragma unroll
      for (int ks = 0; ks < 2; ++ks) {
        u32x4 a, c;
        a[0] = pk2(s0[8 * ks + 0], s0[8 * ks + 1]); a[1] = pk2(s0[8 * ks + 2], s0[8 * ks + 3]); a[2] = pk2(s0[8 * ks + 4], s0[8 * ks + 5]); a[3] = pk2(s0[8 * ks + 6], s0[8 * ks + 7]);
        c[0] = pk2(s1[8 * ks + 0], s1[8 * ks + 1]); c[1] = pk2(s1[8 * ks + 2], s1[8 * ks + 3]); c[2] = pk2(s1[8 * ks + 4], s1[8 * ks + 5]); c[3] = pk2(s1[8 * ks + 6], s1[8 * ks + 7]);
        pf[0][ks] = __builtin_bit_cast(bf16x8, a); pf[1][ks] = __builtin_bit_cast(bf16x8, c);
      }
#pragma unroll
      for (int pbk = 0; pbk < 2; ++pbk)
#pragma unroll
        for (int ks = 0; ks < 2; ++ks)
#pragma unroll
          for (int db = 0; db < 2; ++db) {
            const int off = st + AT_V + (32 * db + l32) * LROW + (32 * pbk + 16 * ks + 4 * hi) * 2;
            const u32x2 lo = *(const u32x2*)(smem + off), hh = *(const u32x2*)(smem + off + 16);
            u32x4 vv; vv[0] = lo[0]; vv[1] = lo[1]; vv[2] = hh[0]; vv[3] = hh[1];
            o[db] = __builtin_amdgcn_mfma_f32_32x32x16_bf16(__builtin_bit_cast(bf16x8, vv), pf[pbk][ks], o[db], 0, 0, 0);
          }
    }
    if (more) AT_STORE(gbase + ((t + 1) & 1) * AT_STG);
    __syncthreads();
  }
#undef AT_LOAD
#undef AT_STORE
  l += __shfl_xor(l, 32);
  const float inv = 1.f / l;
#pragma unroll
  for (int db = 0; db < 2; ++db)
#pragma unroll
    for (int rq = 0; rq < 4; ++rq) {
      u32x2 ov; ov[0] = pk2(o[db][4 * rq] * inv, o[db][4 * rq + 1] * inv); ov[1] = pk2(o[db][4 * rq + 2] * inv, o[db][4 * rq + 3] * inv);
      *(u32x2*)(ycat + (size_t)tokq * DM + 512 + h * 64 + 32 * db + 8 * rq + 4 * hi) = ov;
    }
}
DEV void conv_mixer(const Params& P, int p) {
  const int c = tid_l(), m0 = p * 128, s0 = m0 % SEQ;
  const bf16_t* z = (const bf16_t*)(P.ws + WS_Z);
  bf16_t* ycat = (bf16_t*)(P.ws + WS_HN);
  const float w0 = P.even_conv_w[c], w1 = P.even_conv_w[512 + c], w2 = P.even_conv_w[1024 + c];
  float g2 = 0.f, g1 = 0.f;
  if (s0 > 0) {
    const bf16_t* r2 = z + (size_t)(m0 - 2) * 3072, *r1 = z + (size_t)(m0 - 1) * 3072;
    g2 = bf2f(r2[512 + c]) * bf2f(r2[1024 + c]); g1 = bf2f(r1[512 + c]) * bf2f(r1[1024 + c]);
  }
  for (int t = 0; t < 128; ++t) {
    const bf16_t* r = z + (size_t)(m0 + t) * 3072;
    const float g0 = bf2f(r[512 + c]) * bf2f(r[1024 + c]);
    const float y = bf2f(r[c]) * (w0 * g2 + w1 * g1 + w2 * g0);
    ycat[(size_t)(m0 + t) * DM + c] = f2bf(y);
    g2 = g1; g1 = g0;
  }
}

DEV unsigned fkey(float x) { const unsigned u = __float_as_uint(x); return (u & 0x80000000u) ? ~u : (u | 0x80000000u); }
DEV float keyf(unsigned k) { const unsigned u = (k & 0x80000000u) ? (k & 0x7fffffffu) : ~k; return __uint_as_float(u); }
DEV void ins16(unsigned (&L)[16], unsigned key) {
#pragma unroll
  for (int j = 0; j < 16; ++j) { const unsigned a = L[j]; L[j] = max(a, key); key = min(a, key); }
}
DEV void stage1(unsigned (&L)[16], const float* sp) {
#pragma unroll
  for (int j = 0; j < 16; ++j) L[j] = 0u;
#pragma nounroll
  for (int i = 0; i < 128; i += 8) {
    float v[8];
#pragma unroll
    for (int e = 0; e < 8; ++e) v[e] = sp[(size_t)(i + e) * 128];
#pragma unroll
    for (int e = 0; e < 8; ++e) ins16(L, (fkey(v[e]) & ~127u) | (unsigned)(127 - (i + e)));
  }
}
DEV void topk_group(int hg, const float* scoresT, int* idxo, float* go) {
  const int tid = tid_l(), token = tid & 127, hl = tid >> 7;
  unsigned LA[16], LB[16], LC[16];
  stage1(LA, scoresT + (size_t)(hl * 256) * 128 + token);
  stage1(LB, scoresT + (size_t)(hl * 256 + 128) * 128 + token);
  unsigned* la = (unsigned*)smem; unsigned* lb = la + 16 * 512;
  float bv[16];
#pragma unroll
  for (int j = 0; j < 16; ++j) { LC[j] = 0u; bv[j] = keyf(LB[j] & ~127u); la[j * 512 + tid] = LA[j]; lb[j * 512 + tid] = LB[j]; }
#pragma unroll
  for (int i = 0; i < 16; ++i) {
    const float av = keyf(LA[i] & ~127u);
#pragma unroll
    for (int j = 0; j < 16; ++j)
      if ((i + 1) * (j + 1) <= 16) ins16(LC, (fkey(av + bv[j]) & ~255u) | (unsigned)(255 - (i * 16 + j)));
  }
  const float smax = keyf(LC[0] & ~255u);
  float ev[16], sum = 0.f;
#pragma unroll
  for (int k = 0; k < 16; ++k) { ev[k] = __expf(keyf(LC[k] & ~255u) - smax); sum += ev[k]; }
  const float inv = 1.f / sum;
  const int head = hg * 4 + hl;
#pragma unroll
  for (int k = 0; k < 16; ++k) {
    const int c = 255 - (int)(LC[k] & 255u), i = c >> 4, j = c & 15;
    const int i1 = 127 - (int)(la[i * 512 + tid] & 127u), i2 = 127 - (int)(lb[j * 512 + tid] & 127u);
    idxo[token * 128 + head * 16 + k] = i1 * 128 + i2;
    go[token * 128 + head * 16 + k] = ev[k] * inv;
  }
}
DEV float sw32sum(float a, float b) { auto r = __builtin_amdgcn_permlane32_swap(__float_as_uint(a), __float_as_uint(b), false, false); return __uint_as_float(r[0]) + __uint_as_float(r[1]); }
DEV float sw16sum(float a, float b) { auto r = __builtin_amdgcn_permlane16_swap(__float_as_uint(a), __float_as_uint(b), false, false); return __uint_as_float(r[0]) + __uint_as_float(r[1]); }
template <int N> DEV float row_ror_add(float v) { return v + __uint_as_float((unsigned)__builtin_amdgcn_update_dpp(0, (int)__float_as_uint(v), 0x120 + N, 0xf, 0xf, false)); }
DEV float row_allsum(float v) { v = row_ror_add<8>(v); v = row_ror_add<4>(v); v = row_ror_add<2>(v); v = row_ror_add<1>(v); return v; }
DEV f32x2_t fp8x2(unsigned d, bool hiw) { return hiw ? __builtin_amdgcn_cvt_pk_f32_fp8((int)d, true) : __builtin_amdgcn_cvt_pk_f32_fp8((int)d, false); }
constexpr float TAB_SCALE = 64.f, TAB_INV = 1.f / 64.f;
DEV void peer_gather(const Params& P, int l, int m0, const int* idxs, const float* gs) {
  const int tid = tid_l(), lane = tid & 63, wid = tid >> 6;
  const unsigned char* U = P.ws + WS_TAB + (size_t)l * 32 * MB;
  const unsigned char* V = U + 16 * MB;
  bf16_t* hn = (bf16_t*)(P.ws + WS_HN);
  const float* gp = P.norm_ple + l * DM;
  const int row = lane >> 4, rmap = ((row & 1) << 1) | (row >> 1);
#pragma nounroll
  for (int i = 0; i < 16; ++i) {
    const int tt = wid * 16 + i; const size_t tok = (size_t)(m0 + tt);
    const u32x4 xa = *(const u32x4*)(hn + tok * DM + lane * 16), xb = *(const u32x4*)(hn + tok * DM + lane * 16 + 8);
    f32x2_t xp[8];
#pragma unroll
    for (int q = 0; q < 4; ++q) { xp[q] = (f32x2_t){bflo(xa[q]), bfhi(xa[q])}; xp[4 + q] = (f32x2_t){bflo(xb[q]), bfhi(xb[q])}; }
    const int myi0 = idxs[tt * 128 + lane], myi1 = idxs[tt * 128 + 64 + lane];
    f32x2_t acc[8];
#pragma unroll
    for (int q = 0; q < 8; ++q) acc[q] = (f32x2_t){0.f, 0.f};
    u32x4 ub0[8], vb0[8], ub1[8], vb1[8];
#define PG_ISSUE(UB, VB, e0_) do { const int isrc_ = ((e0_) < 64) ? myi0 : myi1; \
      _Pragma("unroll") for (int e = 0; e < 8; ++e) { const int idx_ = __builtin_amdgcn_readlane(isrc_, ((e0_) + e) & 63); \
        UB[e] = *(const u32x4*)(U + (size_t)idx_ * 1024 + lane * 16); VB[e] = *(const u32x4*)(V + (size_t)idx_ * 1024 + lane * 16); } } while (0)
#define PG_COMPUTE(UB, VB, e0_) do { float d_[8]; \
      _Pragma("unroll") for (int e = 0; e < 8; ++e) { f32x2_t s_ = {0.f, 0.f}; \
        _Pragma("unroll") for (int q = 0; q < 4; ++q) { s_ = __builtin_elementwise_fma(xp[2 * q], fp8x2(UB[e][q], false), s_); s_ = __builtin_elementwise_fma(xp[2 * q + 1], fp8x2(UB[e][q], true), s_); } \
        d_[e] = s_[0] + s_[1]; } \
      float s0_ = sw16sum(sw32sum(d_[0], d_[1]), sw32sum(d_[2], d_[3])); \
      float s1_ = sw16sum(sw32sum(d_[4], d_[5]), sw32sum(d_[6], d_[7])); \
      s0_ = row_allsum(s0_) * TAB_INV; s1_ = row_allsum(s1_) * TAB_INV; \
      const float w0_ = gs[tt * 128 + (e0_) + rmap] * gelu_tanh(s0_), w1_ = gs[tt * 128 + (e0_) + 4 + rmap] * gelu_tanh(s1_); \
      _Pragma("unroll") for (int e = 0; e < 8; ++e) { const int rw_ = (((e & 1) << 1) | ((e >> 1) & 1)) * 16; \
        const float we_ = __uint_as_float(__builtin_amdgcn_readlane(__float_as_uint((e < 4) ? w0_ : w1_), rw_)); const f32x2_t w2_ = {we_, we_}; \
        _Pragma("unroll") for (int q = 0; q < 4; ++q) { acc[2 * q] = __builtin_elementwise_fma(w2_, fp8x2(VB[e][q], false), acc[2 * q]); acc[2 * q + 1] = __builtin_elementwise_fma(w2_, fp8x2(VB[e][q], true), acc[2 * q + 1]); } } } while (0)
    PG_ISSUE(ub0, vb0, 0);
#pragma nounroll
    for (int e0 = 0; e0 < 128; e0 += 16) {
      PG_ISSUE(ub1, vb1, e0 + 8);
      PG_COMPUTE(ub0, vb0, e0);
      if (e0 + 16 < 128) PG_ISSUE(ub0, vb0, e0 + 16);
      PG_COMPUTE(ub1, vb1, e0 + 8);
    }
#undef PG_ISSUE
#undef PG_COMPUTE
    float* hrow = P.out + tok * DM + lane * 16;
    f32x4 hv[4]; float ss = 0.f;
#pragma unroll
    for (int q = 0; q < 4; ++q) {
      hv[q] = *(const f32x4*)(hrow + 4 * q);
      hv[q][0] += acc[2 * q][0] * TAB_INV; hv[q][1] += acc[2 * q][1] * TAB_INV; hv[q][2] += acc[2 * q + 1][0] * TAB_INV; hv[q][3] += acc[2 * q + 1][1] * TAB_INV;
      ss += hv[q][0] * hv[q][0] + hv[q][1] * hv[q][1] + hv[q][2] * hv[q][2] + hv[q][3] * hv[q][3];
      *(f32x4*)(hrow + 4 * q) = hv[q];
    }
    const float rstd = rsqrtf(wave_sum(ss) * (1.f / DM) + EPS);
    u32x4 oa, ob;
#pragma unroll
    for (int q = 0; q < 4; ++q) {
      const f32x4 g = *(const f32x4*)(gp + lane * 16 + 4 * q);
      const unsigned p0 = pk2(hv[q][0] * rstd * g[0], hv[q][1] * rstd * g[1]), p1 = pk2(hv[q][2] * rstd * g[2], hv[q][3] * rstd * g[3]);
      if (q < 2) { oa[2 * q] = p0; oa[2 * q + 1] = p1; } else { ob[2 * (q - 2)] = p0; ob[2 * (q - 2) + 1] = p1; }
    }
    *(u32x4*)(hn + tok * DM + lane * 16) = oa; *(u32x4*)(hn + tok * DM + lane * 16 + 8) = ob;
  }
}
DEV void resid_gemm(const Params& P, int m0, const bf16_t* A, const bf16_t* Wt, const float* base) {
  GEO
#pragma nounroll
  for (int nt = 0; nt < 4; ++nt) {
    f32x16 acc[2][2]; acc_zero(acc);
    gemm_kloop(acc, A + (size_t)m0 * DM, DM, Wt + (size_t)nt * 256 * DM, DM, DM);
    FOR_ACC {
      const int tok = m0 + 64 * wm + 32 * mb + l32, col = nt * 256 + 64 * wn + 32 * nb + 8 * rq + 4 * hi;
      f32x4 v = *(const f32x4*)(base + (size_t)tok * DM + col);
#pragma unroll
      for (int e = 0; e < 4; ++e) v[e] += acc[nb][mb][4 * rq + e];
      *(f32x4*)(P.out + (size_t)tok * DM + col) = v;
    }
  }
}
DEV void chain_peer_ple(const Params& P, int l, int p) {
  GEO
  const int m0 = p * 128;
  bf16_t* hn = (bf16_t*)(P.ws + WS_HN);
  unsigned char* slice = P.ws + WS_Z + (size_t)p * SLICE;
  float* scoresT = (float*)slice; int* idxs = (int*)(slice + 512 * 1024); float* gs = (float*)(slice + 576 * 1024);
  __syncthreads();
  panel_rmsnorm(P.out, P.norm_ffn + l * DM, hn, m0);
  const bf16_t* wpt = (const bf16_t*)(P.ws + W_PT) + (size_t)l * 2048 * 1024;
#pragma nounroll
  for (int hg = 0; hg < 2; ++hg) {
#pragma nounroll
  for (int nt = 0; nt < 4; ++nt) {
      f32x16 acc[2][2]; acc_zero(acc);
      gemm_kloop(acc, hn + (size_t)m0 * DM, DM, wpt + (size_t)((hg * 4 + nt) * 256) * DM, DM, DM);
      FOR_ACC {
        const int tr = 64 * wm + 32 * mb + l32, col = nt * 256 + 64 * wn + 32 * nb + 8 * rq + 4 * hi;
#pragma unroll
        for (int e = 0; e < 4; ++e) scoresT[(size_t)(col + e) * 128 + tr] = acc[nb][mb][4 * rq + e];
      }
    }
    __syncthreads();
    topk_group(hg, scoresT, idxs, gs);
    __syncthreads();
  }
  peer_gather(P, l, m0, idxs, gs);
  __syncthreads();
  const bf16_t* wg = (const bf16_t*)(P.ws + W_GATE) + (size_t)l * 1024 * 1024;
  const bf16_t* wu = (const bf16_t*)(P.ws + W_UP) + (size_t)l * 1024 * 256;
  const bf16_t* pb = (const bf16_t*)(P.ws + WS_PB) + ((size_t)l * T_TOK + m0) * 256;
#pragma nounroll
  for (int nt = 0; nt < 4; ++nt) {
    unsigned sg[2][2][8];
    {
      f32x16 ag[2][2]; acc_zero(ag);
      gemm_kloop(ag, hn + (size_t)m0 * DM, DM, wg + (size_t)nt * 256 * DM, DM, DM);
#pragma unroll
      for (int nb = 0; nb < 2; ++nb)
#pragma unroll
        for (int mb = 0; mb < 2; ++mb)
#pragma unroll
          for (int q = 0; q < 8; ++q) sg[nb][mb][q] = pk2(sigmoidf_(ag[nb][mb][2 * q]), sigmoidf_(ag[nb][mb][2 * q + 1]));
    }
    f32x16 au[2][2]; acc_zero(au);
    gemm_kloop(au, pb, 256, wu + (size_t)nt * 256 * 256, 256, 256);
    FOR_ACC {
      const int tok = m0 + 64 * wm + 32 * mb + l32, col = nt * 256 + 64 * wn + 32 * nb + 8 * rq + 4 * hi;
      f32x4 v = *(const f32x4*)(P.out + (size_t)tok * DM + col);
      v[0] += au[nb][mb][4 * rq + 0] * bflo(sg[nb][mb][2 * rq]); v[1] += au[nb][mb][4 * rq + 1] * bfhi(sg[nb][mb][2 * rq]);
      v[2] += au[nb][mb][4 * rq + 2] * bflo(sg[nb][mb][2 * rq + 1]); v[3] += au[nb][mb][4 * rq + 3] * bfhi(sg[nb][mb][2 * rq + 1]);
      *(f32x4*)(P.out + (size_t)tok * DM + col) = v;
    }
  }
  __syncthreads();
}

DEV void l1_inproj(const Params& P, int p) {
  GEO
  const int m0 = p * 128;
  bf16_t* hn = (bf16_t*)(P.ws + WS_HN);
  bf16_t* zz = (bf16_t*)(P.ws + WS_Z + (size_t)p * SLICE);
  panel_rmsnorm(P.out, P.norm_mix + DM, hn, m0);
  const bf16_t* wt = (const bf16_t*)(P.ws + W_IN1);
#pragma nounroll
  for (int nt = 0; nt < 8; ++nt) {
    f32x16 acc[2][2]; acc_zero(acc);
    gemm_kloop(acc, hn + (size_t)m0 * DM, DM, wt + (size_t)nt * 256 * DM, DM, DM);
    FOR_ACC {
      const int tr = 64 * wm + 32 * mb + l32, col = nt * 256 + 64 * wn + 32 * nb + 8 * rq + 4 * hi;
      u32x2 o; o[0] = pk2(acc[nb][mb][4 * rq], acc[nb][mb][4 * rq + 1]); o[1] = pk2(acc[nb][mb][4 * rq + 2], acc[nb][mb][4 * rq + 3]);
      *(u32x2*)(zz + (size_t)tr * 2048 + col) = o;
    }
  }
}
DEV void p4_panel(const Params& P, int p) {
  GEO
  const int m0 = p * 128, s0 = m0 % SEQ;
  bf16_t* xrc = (bf16_t*)(P.ws + WS_HN);
  const bf16_t* zz = (const bf16_t*)(P.ws + WS_Z + (size_t)p * SLICE);
  const bf16_t* zzp = (const bf16_t*)(P.ws + WS_Z + (size_t)(p - 1) * SLICE);
  bf16_t* la = (bf16_t*)(P.ws + WS_TAB + 64 * MB);
  bf16_t* ub = (bf16_t*)(P.ws + WS_Z + (size_t)p * SLICE + 512 * 1024);
  __syncthreads();
#pragma unroll
  for (int q = 0; q < 2; ++q) {
    const int ch = tid + q * 512;
    const float w0 = P.odd_conv_w[ch], w1 = P.odd_conv_w[1024 + ch], w2 = P.odd_conv_w[2048 + ch], w3 = P.odd_conv_w[3072 + ch], cb = P.odd_conv_b[ch];
    float x3 = 0.f, x2 = 0.f, x1 = 0.f;
    if (s0 > 0) { x3 = bf2f(zzp[(size_t)125 * 2048 + 1024 + ch]); x2 = bf2f(zzp[(size_t)126 * 2048 + 1024 + ch]); x1 = bf2f(zzp[(size_t)127 * 2048 + 1024 + ch]); }
    for (int t = 0; t < 128; ++t) {
      const float x0 = bf2f(zz[(size_t)t * 2048 + 1024 + ch]);
      xrc[(size_t)(m0 + t) * DM + ch] = f2bf(w0 * x3 + w1 * x2 + w2 * x1 + w3 * x0 + cb);
      x3 = x2; x2 = x1; x1 = x0;
    }
  }
  __syncthreads();
  const bf16_t* wax = (const bf16_t*)(P.ws + W_AX);
#pragma nounroll
  for (int h = 0; h < 8; ++h) {
    f32x16 acc[2][2]; acc_zero(acc);
    gemm_kloop(acc, xrc + (size_t)m0 * DM + h * 128, DM, wax + (size_t)h * 256 * 128, 128, 128);
#pragma unroll
    for (int rq = 0; rq < 4; ++rq) {
      const int ch = h * 128 + 32 * wn + 8 * rq + 4 * hi;
      const f32x4 ba = *(const f32x4*)(P.odd_b_a + ch), bx = *(const f32x4*)(P.odd_b_x + ch), lp = *(const f32x4*)(P.odd_lru + ch);
      float sp[4];
#pragma unroll
      for (int e = 0; e < 4; ++e) { const float nl = -lp[e]; sp[e] = fmaxf(nl, 0.f) + log1pf(__expf(-fabsf(nl))); }
#pragma unroll
      for (int mb = 0; mb < 2; ++mb) {
        const int tr = 64 * wm + 32 * mb + l32; const size_t tok = (size_t)(m0 + tr);
        const u32x2 xr = *(const u32x2*)(xrc + tok * DM + ch);
        const float xv[4] = {bflo(xr[0]), bfhi(xr[0]), bflo(xr[1]), bfhi(xr[1])};
        float lav[4], uv[4];
#pragma unroll
        for (int e = 0; e < 4; ++e) {
          const float rg = sigmoidf_(acc[0][mb][4 * rq + e] + ba[e]), ig = sigmoidf_(acc[1][mb][4 * rq + e] + bx[e]);
          lav[e] = -8.f * rg * sp[e];
          uv[e] = sqrtf(-expm1f(2.f * lav[e])) * (ig * xv[e]);
        }
        u32x2 o1, o2; o1[0] = pk2(lav[0], lav[1]); o1[1] = pk2(lav[2], lav[3]); o2[0] = pk2(uv[0], uv[1]); o2[1] = pk2(uv[2], uv[3]);
        *(u32x2*)(la + tok * DM + ch) = o1;
        *(u32x2*)(ub + (size_t)tr * DM + ch) = o2;
      }
    }
  }
  __syncthreads();
  float* aprod = (float*)(P.ws + WS_APROD); float* hend = (float*)(P.ws + WS_HEND);
#pragma unroll
  for (int q = 0; q < 2; ++q) {
    const int ch = tid + q * 512;
    float Asum = 0.f, H = 0.f;
    for (int t = 0; t < 128; ++t) {
      const float lv = bf2f(la[(size_t)(m0 + t) * DM + ch]), u = bf2f(ub[(size_t)t * DM + ch]);
      H = __expf(lv) * H + u; Asum += lv;
    }
    aprod[p * DM + ch] = __expf(Asum); hend[p * DM + ch] = H;
  }
}
DEV void p5_pre(const Params& P, int p) {
  GEO
  const int m0 = p * 128;
  const int pfirst = (p >> 7) << 7;
  const float* aprod = (const float*)(P.ws + WS_APROD); const float* hend = (const float*)(P.ws + WS_HEND);
  const bf16_t* la = (const bf16_t*)(P.ws + WS_TAB + 64 * MB);
  const bf16_t* ub = (const bf16_t*)(P.ws + WS_Z + (size_t)p * SLICE + 512 * 1024);
  const bf16_t* zz = (const bf16_t*)(P.ws + WS_Z + (size_t)p * SLICE);
  bf16_t* y = (bf16_t*)(P.ws + WS_HN);
  __syncthreads();
#pragma unroll
  for (int q = 0; q < 2; ++q) {
    const int ch = tid + q * 512;
    float H = 0.f;
#pragma unroll 8
    for (int pp = pfirst; pp < p; ++pp) H = aprod[pp * DM + ch] * H + hend[pp * DM + ch];
    for (int t = 0; t < 128; ++t) {
      const float lv = bf2f(la[(size_t)(m0 + t) * DM + ch]), u = bf2f(ub[(size_t)t * DM + ch]);
      H = __expf(lv) * H + u;
      const float gt_ = bf2f(zz[(size_t)t * 2048 + ch]);
      y[(size_t)(m0 + t) * DM + ch] = f2bf(H * gelu_tanh(gt_));
    }
  }
  __syncthreads();
}

__global__ void __launch_bounds__(512) mega(Params P) {
  cg::grid_group grid = cg::this_grid();
  const int tid = threadIdx.x;
  unsigned char* ws = P.ws;
  transpose_job(P.even_w_in, 1024, 3072, 3080, (bf16_t*)(ws + W_IN0), 1024);
  transpose_job(P.even_w_out, 1024, 1024, 1024, (bf16_t*)(ws + W_OUT0), 1024);
  transpose_job(P.odd_w_in, 1024, 2048, 2048, (bf16_t*)(ws + W_IN1), 1024);
  transpose_job(P.odd_w_out, 1024, 1024, 1024, (bf16_t*)(ws + W_OUT1), 1024);
#pragma nounroll
  for (int l = 0; l < 2; ++l) {
    transpose_job(P.ple_up + (size_t)l * 256 * 1024, 256, 1024, 1024, (bf16_t*)(ws + W_UP) + (size_t)l * 1024 * 256, 256);
    transpose_job(P.ple_gate + (size_t)l * 1024 * 1024, 1024, 1024, 1024, (bf16_t*)(ws + W_GATE) + (size_t)l * 1024 * 1024, 1024);
  }
  convert_job(P.peer_wq, (bf16_t*)(ws + W_QB), (size_t)2 * 1024 * 2048);
  convert_job(P.p, (bf16_t*)(ws + WS_PB), (size_t)2 * T_TOK * 256);
#pragma nounroll
  for (int l = 0; l < 2; ++l) {
    convert_fp8_job(P.peer_u + (size_t)l * 16384 * 1024, ws + WS_TAB + (size_t)(2 * l) * 16 * MB, (size_t)16384 * 1024);
    convert_fp8_job(P.peer_v + (size_t)l * 16384 * 1024, ws + WS_TAB + (size_t)(2 * l + 1) * 16 * MB, (size_t)16384 * 1024);
  }
  {
    const int gsz = gridDim.x * 512, gid = blockIdx.x * 512 + tid;
    bf16_t* bsk = (bf16_t*)(ws + W_SK);
    for (int i = gid; i < 2 * 65536; i += gsz) {
      const int l = i >> 16, n = (i >> 8) & 255, k = i & 255;
      float v = 0.f;
      if ((n < 128) == (k < 128)) v = P.peer_sk[(size_t)l * 32768 + (size_t)(n >> 7) * 16384 + (n & 127) * 128 + (k & 127)];
      bsk[i] = f2bf(v);
    }
    bf16_t* wax = (bf16_t*)(ws + W_AX);
    for (int i = gid; i < 8 * 256 * 128; i += gsz) {
      const int h = i >> 15, n = (i >> 7) & 255, k = i & 127;
      const int wn = n >> 6, nb = (n >> 5) & 1, jj = n & 31;
      const float* src = nb ? P.odd_w_x : P.odd_w_a;
      wax[i] = f2bf(src[(size_t)h * 16384 + k * 128 + 32 * wn + jj]);
    }
  }
  grid.sync();
#pragma nounroll
  for (int p = blockIdx.x; p < NPANEL; p += gridDim.x) { asm volatile("" ::: "memory"); p1_panel(P, p); }
#pragma nounroll
  for (int u = blockIdx.x; u < 128; u += gridDim.x) { asm volatile("" ::: "memory"); fold_unit(P, u); }
  grid.sync();
#pragma nounroll
  for (int blk = blockIdx.x; blk < 256; blk += gridDim.x) {
    asm volatile("" ::: "memory");
    const int bh = blk & 7, s = blk >> 3, b = bh >> 2, hp = bh & 3;
    attn_unit(P, b, 127 - s, hp);
    attn_unit(P, b, 64 + s, hp);
    attn_unit(P, b, 63 - s, hp);
    attn_unit(P, b, s, hp);
  }
#pragma nounroll
  for (int p = blockIdx.x; p < NPANEL; p += gridDim.x) { asm volatile("" ::: "memory"); conv_mixer(P, p); }
  grid.sync();
#pragma nounroll
  for (int p = blockIdx.x; p < NPANEL; p += gridDim.x) {
    Params Q = P; asm volatile("" : "+s"(Q.ws), "+s"(Q.out) :: "memory");
    resid_gemm(Q, p * 128, (const bf16_t*)(Q.ws + WS_HN), (const bf16_t*)(Q.ws + W_OUT0), Q.x);
    chain_peer_ple(Q, 0, p);
    l1_inproj(Q, p);
  }
  grid.sync();
#pragma nounroll
  for (int p = blockIdx.x; p < NPANEL; p += gridDim.x) { asm volatile("" ::: "memory"); p4_panel(P, p); }
  grid.sync();
#pragma nounroll
  for (int p = blockIdx.x; p < NPANEL; p += gridDim.x) {
    Params Q = P; asm volatile("" : "+s"(Q.ws), "+s"(Q.out) :: "memory");
    p5_pre(Q, p);
    resid_gemm(Q, p * 128, (const bf16_t*)(Q.ws + WS_HN), (const bf16_t*)(Q.ws + W_OUT1), Q.out);
    chain_peer_ple(Q, 1, p);
  }
}

extern "C" void kernel_launch(void* const* d_in, const int* in_sizes, int n_in, void* d_out, int out_size, void* d_ws, size_t ws_size, hipStream_t stream) {
  static int grid_blocks = 0;
  if (grid_blocks == 0) {
    if (n_in != 26 || ws_size < WS_END) { fprintf(stderr, "kernel_launch: unexpected n_in %d / ws_size %zu\n", n_in, ws_size); grid_blocks = -1; return; }
    int dev = 0, cus = 0, per_cu = 0;
    (void)hipGetDevice(&dev);
    (void)hipDeviceGetAttribute(&cus, hipDeviceAttributeMultiprocessorCount, dev);
    (void)hipFuncSetAttribute((const void*)mega, hipFuncAttributeMaxDynamicSharedMemorySize, LDS_BYTES);
    (void)hipOccupancyMaxActiveBlocksPerMultiprocessor(&per_cu, (const void*)mega, 512, LDS_BYTES);
    if (per_cu < 1) { fprintf(stderr, "kernel_launch: occupancy query reports 0 blocks per CU\n"); grid_blocks = -1; return; }
    grid_blocks = cus;
    if (grid_blocks > 256) grid_blocks = 256;
  }
  if (grid_blocks < 0) return;
  Params P{};
  const float** pp = (const float**)&P;
  for (int i = 0; i < 26; ++i) pp[i] = (const float*)d_in[i];
  P.out = (float*)d_out; P.ws = (unsigned char*)d_ws;
  void* args[] = {&P};
  hipError_t e = hipLaunchCooperativeKernel((const void*)mega, dim3(grid_blocks), dim3(512), args, LDS_BYTES, stream);
  if (e != hipSuccess) fprintf(stderr, "cooperative launch failed: %s (grid %d)\n", hipGetErrorString(e), grid_blocks);
}
```

```cpp
#include <hip/hip_runtime.h>
#include <hip/hip_cooperative_groups.h>
#include <stdint.h>
#include <cstdio>
namespace cg = cooperative_groups;

typedef unsigned short bf16_t;
typedef short bf16x8 __attribute__((ext_vector_type(8)));
typedef float f32x16 __attribute__((ext_vector_type(16)));
typedef float f32x4 __attribute__((ext_vector_type(4)));
typedef unsigned u32x4 __attribute__((ext_vector_type(4)));
typedef unsigned u32x2 __attribute__((ext_vector_type(2)));
typedef float f32x2_t __attribute__((ext_vector_type(2)));
typedef __bf16 bf16x2_t __attribute__((ext_vector_type(2)));
#define DEV __device__ __forceinline__

constexpr int T_TOK = 32768, SEQ = 16384, DM = 1024, NPANEL = 256;
constexpr float EPS = 1e-6f, LOG2E = 1.4426950408889634f;
constexpr size_t MB = 1u << 20;
constexpr size_t WS_FLOC = 0;
constexpr size_t WS_PTOT = 1 * MB;
constexpr size_t WS_APROD = 2 * MB;
constexpr size_t WS_HEND = 3 * MB;
constexpr size_t WS_W = 4 * MB;
constexpr size_t W_IN0 = WS_W, W_OUT0 = WS_W + 6 * MB, W_IN1 = WS_W + 8 * MB, W_AX = WS_W + 12 * MB, W_OUT1 = WS_W + 13 * MB,
                 W_QB = WS_W + 15 * MB, W_SK = WS_W + 23 * MB, W_PT = WS_W + 24 * MB, W_UP = WS_W + 32 * MB, W_GATE = WS_W + 33 * MB;
constexpr size_t WS_TAB = 44 * MB;
constexpr size_t WS_PB = 172 * MB;
constexpr size_t WS_HN = 204 * MB;
constexpr size_t WS_Z = 268 * MB;
constexpr size_t WS_VT = 460 * MB;
constexpr size_t WS_END = 492 * MB;
constexpr size_t SLICE = 768 * 1024;

constexpr int LROW = 144;
constexpr int GS_A = 0, GS_B = 16384, GS_STAGE = 49152;
constexpr int LDS_MISC = 3 * GS_STAGE;
constexpr int LDS_BYTES = LDS_MISC + 4096;
typedef __attribute__((address_space(3))) unsigned lds_u32;

extern __shared__ __attribute__((aligned(16))) unsigned char smem[];

struct Params {
  const float *x, *p, *norm_mix, *norm_ffn, *norm_ple, *even_w_in, *even_b_forget, *even_conv_w, *even_q_gain, *even_k_gain, *even_w_out,
      *odd_w_in, *odd_conv_w, *odd_conv_b, *odd_w_a, *odd_b_a, *odd_w_x, *odd_b_x, *odd_lru, *odd_w_out,
      *peer_wq, *peer_sk, *peer_u, *peer_v, *ple_up, *ple_gate;
  float* out; unsigned char* ws;
};

DEV unsigned pk2(float lo, float hi) { f32x2_t v = {lo, hi}; bf16x2_t b = __builtin_convertvector(v, bf16x2_t); return __builtin_bit_cast(unsigned, b); }
DEV float bflo(unsigned u) { return __uint_as_float(u << 16); }
DEV float bfhi(unsigned u) { return __uint_as_float(u & 0xffff0000u); }
DEV float bf2f(bf16_t v) { return __uint_as_float((unsigned)v << 16); }
DEV bf16_t f2bf(float f) { return (bf16_t)(pk2(f, 0.f) & 0xffffu); }
DEV int tid_l() { int t = threadIdx.x; asm volatile("" : "+v"(t)); return t; }
DEV float wave_sum(float v) {
#pragma unroll
  for (int o = 1; o < 64; o <<= 1) v += __shfl_xor(v, o);
  return v;
}
DEV float gelu_tanh(float x) { const float u = 1.5957691216057308f * (x + 0.044715f * x * x * x); return x / (1.f + __expf(-u)); }
DEV float sigmoidf_(float x) { return 1.f / (1.f + __expf(-x)); }

DEV void gemm_kloop(f32x16 (&acc)[2][2], const bf16_t* A, int lda, const bf16_t* Bt, int ldb, int K) {
  const int tid = tid_l(), lane = tid & 63, wid = __builtin_amdgcn_readfirstlane(tid >> 6), wm = wid & 1, wn = wid >> 1, l32 = lane & 31, hi = lane >> 5;
  const int lr = lane >> 3, lc = lane & 7;
  const char* pa[2]; const char* pb[4];
#pragma unroll
  for (int i = 0; i < 2; ++i) { const int r = 8 * (wid + 8 * i) + lr; pa[i] = (const char*)A + ((size_t)r * lda + ((lc ^ ((r >> 1) & 7)) << 3)) * 2; }
#pragma unroll
  for (int i = 0; i < 4; ++i) { const int r = 8 * (wid + 8 * i) + lr; pb[i] = (const char*)Bt + ((size_t)r * ldb + ((lc ^ ((r >> 1) & 7)) << 3)) * 2; }
  const int dsta = GS_A + wid * 1024, dstb = GS_B + wid * 1024;
  const int sw = (l32 >> 1) & 7;
  int xk[4], wk[4];
#pragma unroll
  for (int ks = 0; ks < 4; ++ks) { const int ko = ((2 * ks + hi) ^ sw) << 4; xk[ks] = GS_A + (64 * wm + l32) * 128 + ko; wk[ks] = GS_B + (64 * wn + l32) * 128 + ko; }
  const int nk = K >> 6;
#define GK_DMA(st_, kt_) do { \
    _Pragma("unroll") for (int i = 0; i < 2; ++i) __builtin_amdgcn_global_load_lds((const unsigned*)(pa[i] + (size_t)(kt_) * 128), (lds_u32*)(smem + (st_) + dsta + i * 8192), 16, 0, 0); \
    _Pragma("unroll") for (int i = 0; i < 4; ++i) __builtin_amdgcn_global_load_lds((const unsigned*)(pb[i] + (size_t)(kt_) * 128), (lds_u32*)(smem + (st_) + dstb + i * 8192), 16, 0, 0); } while (0)
#define GK_COMPUTE(st_) do { \
    _Pragma("unroll") for (int ks = 0; ks < 4; ++ks) { \
      bf16x8 xf[2], wf[2]; \
      _Pragma("unroll") for (int mb = 0; mb < 2; ++mb) xf[mb] = *(const bf16x8*)(smem + (st_) + xk[ks] + mb * 4096); \
      _Pragma("unroll") for (int nb = 0; nb < 2; ++nb) wf[nb] = *(const bf16x8*)(smem + (st_) + wk[ks] + nb * 4096); \
      _Pragma("unroll") for (int nb = 0; nb < 2; ++nb) \
        _Pragma("unroll") for (int mb = 0; mb < 2; ++mb) acc[nb][mb] = __builtin_amdgcn_mfma_f32_32x32x16_bf16(wf[nb], xf[mb], acc[nb][mb], 0, 0, 0); } } while (0)
#define GK_WAITBAR(N) do { asm volatile("s_waitcnt vmcnt(" #N ") lgkmcnt(0)" ::: "memory"); __builtin_amdgcn_s_barrier(); asm volatile("" ::: "memory"); } while (0)
  __syncthreads();
  GK_DMA(0, 0);
  GK_DMA(GS_STAGE, 1);
  GK_WAITBAR(6);
  int stc = 0, std_ = 2 * GS_STAGE;
#pragma nounroll
  for (int kt = 0; kt < nk - 2; ++kt) {
    GK_DMA(std_, kt + 2);
    GK_COMPUTE(stc);
    GK_WAITBAR(6);
    stc = (stc == 2 * GS_STAGE) ? 0 : stc + GS_STAGE;
    std_ = (std_ == 2 * GS_STAGE) ? 0 : std_ + GS_STAGE;
  }
  GK_COMPUTE(stc);
  GK_WAITBAR(0);
  stc = (stc == 2 * GS_STAGE) ? 0 : stc + GS_STAGE;
  GK_COMPUTE(stc);
  GK_WAITBAR(0);
#undef GK_DMA
#undef GK_COMPUTE
#undef GK_WAITBAR
}
DEV void epi_resid_f32(const f32x16 (&acc)[2][2], const float* base, float* out, int m0, int n0) {
  const int tid = tid_l(), lane = tid & 63, wid = tid >> 6, wm = wid & 1, wn = wid >> 1, l32 = lane & 31, hi = lane >> 5;
  unsigned char* wl = smem + wid * 8704;
#pragma unroll
  for (int mb = 0; mb < 2; ++mb) {
#pragma unroll
    for (int nb = 0; nb < 2; ++nb)
#pragma unroll
      for (int rq = 0; rq < 4; ++rq) {
        f32x4 v; v[0] = acc[nb][mb][4 * rq]; v[1] = acc[nb][mb][4 * rq + 1]; v[2] = acc[nb][mb][4 * rq + 2]; v[3] = acc[nb][mb][4 * rq + 3];
        *(f32x4*)(wl + l32 * 272 + (32 * nb + 8 * rq + 4 * hi) * 4) = v;
      }
    const size_t o0 = (size_t)(m0 + 64 * wm + 32 * mb + (lane >> 4)) * DM + n0 + 64 * wn + (lane & 15) * 4;
    f32x4 v[8], bb[8];
#pragma unroll
    for (int it = 0; it < 8; ++it) bb[it] = *(const f32x4*)(base + o0 + (size_t)it * 4 * DM);
#pragma unroll
    for (int it = 0; it < 8; ++it) v[it] = *(const f32x4*)(wl + (it * 4 + (lane >> 4)) * 272 + (lane & 15) * 16);
#pragma unroll
    for (int it = 0; it < 8; ++it) *(f32x4*)(out + o0 + (size_t)it * 4 * DM) = v[it] + bb[it];
  }
}
template <class F> DEV void epi_rows_bf16(const f32x16 (&acc)[2][2], F f) {
  const int tid = tid_l(), lane = tid & 63, wid = tid >> 6, wm = wid & 1, wn = wid >> 1, l32 = lane & 31, hi = lane >> 5;
  unsigned char* wl = smem + wid * 4608;
#pragma unroll
  for (int mb = 0; mb < 2; ++mb) {
#pragma unroll
    for (int nb = 0; nb < 2; ++nb)
#pragma unroll
      for (int rq = 0; rq < 4; ++rq) {
        u32x2 o; o[0] = pk2(acc[nb][mb][4 * rq], acc[nb][mb][4 * rq + 1]); o[1] = pk2(acc[nb][mb][4 * rq + 2], acc[nb][mb][4 * rq + 3]);
        *(u32x2*)(wl + l32 * LROW + (32 * nb + 8 * rq + 4 * hi) * 2) = o;
      }
#pragma unroll
    for (int it = 0; it < 4; ++it) {
      const int row = it * 8 + (lane >> 3), c8 = (lane & 7) * 8;
      const u32x4 v = *(const u32x4*)(wl + row * LROW + c8 * 2);
      f(64 * wm + 32 * mb + row, 64 * wn + c8, v);
    }
  }
}
DEV void acc_zero(f32x16 (&acc)[2][2]) {
#pragma unroll
  for (int a = 0; a < 2; ++a)
#pragma unroll
    for (int b = 0; b < 2; ++b)
#pragma unroll
      for (int r = 0; r < 16; ++r) acc[a][b][r] = 0.f;
}
#define GEO const int tid = tid_l(), lane = tid & 63, wid = tid >> 6, wm = wid & 1, wn = wid >> 1, l32 = lane & 31, hi = lane >> 5; (void)wm; (void)wn; (void)l32; (void)hi; (void)lane; (void)wid;
#define FOR_ACC _Pragma("unroll") for (int nb = 0; nb < 2; ++nb) _Pragma("unroll") for (int mb = 0; mb < 2; ++mb) _Pragma("unroll") for (int rq = 0; rq < 4; ++rq)

DEV void transpose_job(const float* __restrict__ W, int K, int N, int ldw, bf16_t* Wt, int ldt) {
  float* tile = (float*)smem;
  const int tid = tid_l(); const int ntn = N >> 6, ntiles = (K >> 6) * ntn;
  for (int t = blockIdx.x; t < ntiles; t += gridDim.x) {
    const int k0 = (t / ntn) << 6, n0 = (t % ntn) << 6;
    __syncthreads();
#pragma unroll
    for (int q = 0; q < 2; ++q) {
      const int id = tid + q * 512, i = id >> 4, c4 = (id & 15) << 2;
      const f32x4 v = *(const f32x4*)(W + (size_t)(k0 + i) * ldw + n0 + c4);
      tile[i * 65 + c4 + 0] = v[0]; tile[i * 65 + c4 + 1] = v[1]; tile[i * 65 + c4 + 2] = v[2]; tile[i * 65 + c4 + 3] = v[3];
    }
    __syncthreads();
    const int n = tid >> 3, kc = (tid & 7) << 3;
    u32x4 o;
    o[0] = pk2(tile[(kc + 0) * 65 + n], tile[(kc + 1) * 65 + n]); o[1] = pk2(tile[(kc + 2) * 65 + n], tile[(kc + 3) * 65 + n]);
    o[2] = pk2(tile[(kc + 4) * 65 + n], tile[(kc + 5) * 65 + n]); o[3] = pk2(tile[(kc + 6) * 65 + n], tile[(kc + 7) * 65 + n]);
    *(u32x4*)(Wt + (size_t)(n0 + n) * ldt + k0 + kc) = o;
  }
  __syncthreads();
}
DEV void convert_job(const float* __restrict__ src, bf16_t* dst, size_t n) {
  const size_t stride = (size_t)gridDim.x * 512 * 8;
  for (size_t i = ((size_t)blockIdx.x * 512 + threadIdx.x) * 8; i < n; i += stride) {
    const f32x4 a = *(const f32x4*)(src + i), b = *(const f32x4*)(src + i + 4);
    u32x4 o; o[0] = pk2(a[0], a[1]); o[1] = pk2(a[2], a[3]); o[2] = pk2(b[0], b[1]); o[3] = pk2(b[2], b[3]);
    *(u32x4*)(dst + i) = o;
  }
}

DEV void convert_fp8_job(const float* __restrict__ src, unsigned char* dst, size_t n) {
  const size_t stride = (size_t)gridDim.x * 512 * 16;
  for (size_t i = ((size_t)blockIdx.x * 512 + threadIdx.x) * 16; i < n; i += stride) {
    u32x4 o;
#pragma unroll
    for (int q = 0; q < 4; ++q) {
      const f32x4 a = *(const f32x4*)(src + i + 4 * q);
      int d = __builtin_amdgcn_cvt_pk_fp8_f32(a[0] * 64.f, a[1] * 64.f, 0, false);
      d = __builtin_amdgcn_cvt_pk_fp8_f32(a[2] * 64.f, a[3] * 64.f, d, true);
      o[q] = (unsigned)d;
    }
    *(u32x4*)(dst + i) = o;
  }
}
DEV void panel_rmsnorm(const float* src, const float* __restrict__ gain, bf16_t* dst, int m0) {
  GEO
  f32x4 g[4];
#pragma unroll
  for (int j = 0; j < 4; ++j) g[j] = *(const f32x4*)(gain + j * 256 + lane * 4);
#pragma nounroll
  for (int i = 0; i < 16; ++i) {
    const size_t row = (size_t)(m0 + wid * 16 + i) * DM;
    f32x4 v[4]; float s = 0.f;
#pragma unroll
    for (int j = 0; j < 4; ++j) { v[j] = *(const f32x4*)(src + row + j * 256 + lane * 4); s += v[j][0] * v[j][0] + v[j][1] * v[j][1] + v[j][2] * v[j][2] + v[j][3] * v[j][3]; }
    const float rstd = rsqrtf(wave_sum(s) * (1.f / DM) + EPS);
#pragma unroll
    for (int j = 0; j < 4; ++j) {
      u32x2 o; o[0] = pk2(v[j][0] * rstd * g[j][0], v[j][1] * rstd * g[j][1]); o[1] = pk2(v[j][2] * rstd * g[j][2], v[j][3] * rstd * g[j][3]);
      *(u32x2*)(dst + row + j * 256 + lane * 4) = o;
    }
  }
}

DEV void p1_panel(const Params& P, int p) {
  GEO
  const int m0 = p * 128;
  bf16_t* hn = (bf16_t*)(P.ws + WS_HN);
  bf16_t* z = (bf16_t*)(P.ws + WS_Z);
  bf16_t* vt = (bf16_t*)(P.ws + WS_VT);
  float* floc = (float*)(P.ws + WS_FLOC);
  float* ptot = (float*)(P.ws + WS_PTOT);
  float* lf = (float*)(smem + LDS_MISC);
  {
    float wfr[4][4][8]; f32x4 g[4];
#pragma unroll
    for (int j = 0; j < 4; ++j) {
      g[j] = *(const f32x4*)(P.norm_mix + j * 256 + lane * 4);
#pragma unroll
      for (int e = 0; e < 4; ++e) {
        const float* wp = P.even_w_in + (size_t)(j * 256 + lane * 4 + e) * 3080 + 3072;
        const f32x4 a = *(const f32x4*)wp, b = *(const f32x4*)(wp + 4);
        wfr[j][e][0] = a[0]; wfr[j][e][1] = a[1]; wfr[j][e][2] = a[2]; wfr[j][e][3] = a[3];
        wfr[j][e][4] = b[0]; wfr[j][e][5] = b[1]; wfr[j][e][6] = b[2]; wfr[j][e][7] = b[3];
      }
    }
  #pragma nounroll
  for (int i = 0; i < 16; ++i) {
      const size_t row = (size_t)(m0 + wid * 16 + i) * DM;
      f32x4 v[4]; float s = 0.f;
#pragma unroll
      for (int j = 0; j < 4; ++j) { v[j] = *(const f32x4*)(P.x + row + j * 256 + lane * 4); s += v[j][0] * v[j][0] + v[j][1] * v[j][1] + v[j][2] * v[j][2] + v[j][3] * v[j][3]; }
      const float rstd = rsqrtf(wave_sum(s) * (1.f / DM) + EPS);
      float fs[8];
#pragma unroll
      for (int h = 0; h < 8; ++h) fs[h] = 0.f;
#pragma unroll
      for (int j = 0; j < 4; ++j) {
        float hv[4];
#pragma unroll
        for (int e = 0; e < 4; ++e) {
          hv[e] = v[j][e] * rstd * g[j][e];
#pragma unroll
          for (int h = 0; h < 8; ++h) fs[h] += hv[e] * wfr[j][e][h];
        }
        u32x2 o; o[0] = pk2(hv[0], hv[1]); o[1] = pk2(hv[2], hv[3]);
        *(u32x2*)(hn + row + j * 256 + lane * 4) = o;
      }
#pragma unroll
      for (int h = 0; h < 8; ++h) fs[h] = wave_sum(fs[h]);
      if (lane < 8) {
        float f = fs[0];
#pragma unroll
        for (int h = 1; h < 8; ++h) f = (lane == h) ? fs[h] : f;
        const float xx = f + P.even_b_forget[lane];
        lf[(wid * 16 + i) * 8 + lane] = fminf(xx, 0.f) - log1pf(__expf(-fabsf(xx)));
      }
    }
  }
  __syncthreads();
  if (tid < 8) {
    const int b = m0 / SEQ, s0 = m0 % SEQ;
    float cum = 0.f; float* fo = floc + (size_t)(b * 8 + tid) * SEQ + s0;
    for (int t = 0; t < 128; ++t) { cum += lf[t * 8 + tid]; fo[t] = cum; }
    ptot[p * 8 + tid] = cum;
  }
  const bf16_t* wt = (const bf16_t*)(P.ws + W_IN0);
#pragma nounroll
  for (int nt = 0; nt < 12; ++nt) {
    f32x16 acc[2][2]; acc_zero(acc);
    gemm_kloop(acc, hn + (size_t)m0 * DM, DM, wt + (size_t)nt * 256 * DM, DM, DM);
    const int n0 = nt * 256;
    if (nt < 10) {
      if (nt >= 6) {
        const bool isq = nt < 8;
        const float* gn = isq ? P.even_q_gain : P.even_k_gain;
        const float extra = isq ? 0.125f * LOG2E : 1.f;
#pragma unroll
        for (int mb = 0; mb < 2; ++mb) {
          float s = 0.f;
#pragma unroll
          for (int nb = 0; nb < 2; ++nb)
#pragma unroll
            for (int r = 0; r < 16; ++r) s += acc[nb][mb][r] * acc[nb][mb][r];
          s += __shfl_xor(s, 32);
          const float rstd = rsqrtf(s * (1.f / 64.f) + EPS) * extra;
#pragma unroll
          for (int nb = 0; nb < 2; ++nb)
#pragma unroll
            for (int rq = 0; rq < 4; ++rq) {
              const f32x4 gg = *(const f32x4*)(gn + 32 * nb + 8 * rq + 4 * hi);
#pragma unroll
              for (int e = 0; e < 4; ++e) acc[nb][mb][4 * rq + e] *= rstd * gg[e];
            }
        }
      }
      epi_rows_bf16(acc, [&](int tr, int cr, u32x4 v) { *(u32x4*)(z + (size_t)(m0 + tr) * 3072 + n0 + cr) = v; });
    } else {
      FOR_ACC {
        const int tok = m0 + 64 * wm + 32 * mb + l32, col = n0 + 64 * wn + 32 * nb + 8 * rq + 4 * hi - 2560;
        const int b = tok / SEQ, s = tok % SEQ;
#pragma unroll
        for (int e = 0; e < 4; ++e) vt[(size_t)(b * 512 + col + e) * SEQ + s] = f2bf(acc[nb][mb][4 * rq + e]);
      }
    }
  }
}
DEV void fold_unit(const Params& P, int u) {
  GEO
  const int l = u >> 6, jt = (u >> 3) & 7, hh = u & 7;
  const bf16_t* A = (const bf16_t*)(P.ws + W_QB) + (size_t)l * 1024 * 2048 + (size_t)(jt * 128) * 2048 + hh * 256;
  const bf16_t* Bt = (const bf16_t*)(P.ws + W_SK) + (size_t)l * 65536;
  bf16_t* wpt = (bf16_t*)(P.ws + W_PT);
  f32x16 acc[2][2]; acc_zero(acc);
  gemm_kloop(acc, A, 2048, Bt, 256, 256);
  FOR_ACC {
    const int j = jt * 128 + 64 * wm + 32 * mb + l32, n = 64 * wn + 32 * nb + 8 * rq + 4 * hi;
#pragma unroll
    for (int e = 0; e < 4; ++e) wpt[((size_t)l * 2048 + hh * 256 + n + e) * 1024 + j] = f2bf(acc[nb][mb][4 * rq + e]);
  }
}

constexpr int AT_K = 0, AT_V = 64 * LROW, AT_BIAS = 128 * LROW, AT_STG = 128 * LROW + 256;
constexpr int AT_GRP = 2 * AT_STG;
constexpr int AT_SUF = 2 * AT_GRP;
DEV int crow(int r, int hi) { return 8 * (r >> 2) + 4 * hi + (r & 3); }

DEV void attn_unit(const Params& P, int b, int qb, int hp) {
  const int tid = tid_l(), lane = tid & 63, wid = tid >> 6, l32 = lane & 31, hi = lane >> 5;
  const int g = wid >> 2, wq = wid & 3, h = 2 * hp + g, gt = tid & 255;
  const bf16_t* z = (const bf16_t*)(P.ws + WS_Z);
  const bf16_t* vt = (const bf16_t*)(P.ws + WS_VT);
  bf16_t* ycat = (bf16_t*)(P.ws + WS_HN);
  const float* fl = (const float*)(P.ws + WS_FLOC) + (size_t)(b * 8 + h) * SEQ;
  const float* ptot = (const float*)(P.ws + WS_PTOT);
  float* suf = (float*)(smem + AT_SUF) + g * 128;
  __syncthreads();
  float val = 0.f;
  if (gt < 128) { val = (gt < qb) ? ptot[(b * 128 + gt) * 8 + h] : 0.f; suf[gt] = val; }
#pragma nounroll
  for (int off = 1; off < 128; off <<= 1) {
    __syncthreads();
    float v2 = 0.f;
    if (gt < 128 && gt + off < 128) v2 = suf[gt + off];
    __syncthreads();
    if (gt < 128) { val += v2; suf[gt] = val; }
  }
  __syncthreads();
  const int tokq = b * SEQ + qb * 128 + wq * 32 + l32;
  bf16x8 qf[4];
#pragma unroll
  for (int d0 = 0; d0 < 4; ++d0) qf[d0] = *(const bf16x8*)(z + (size_t)tokq * 3072 + 1536 + h * 64 + d0 * 16 + hi * 8);
  const float fend = fl[qb * 128 + 127];
  const int kc = gt & 7, kr = gt >> 3;
  const bf16_t* kg = z + (size_t)(b * SEQ + kr) * 3072 + 2048 + h * 64 + kc * 8;
  const bf16_t* vg = vt + (size_t)((b * 8 + h) * 64 + kr) * SEQ + kc * 8;
  const int gbase = g * AT_GRP;
  const int sk_ = kr * LROW + kc * 16;
  const int NT = 2 * qb + 2;
  u32x4 rk[2], rv[2]; float rbias = 0.f;
#define AT_LOAD(t) do { \
    rk[0] = *(const u32x4*)(kg + (size_t)(t) * 64 * 3072); rk[1] = *(const u32x4*)(kg + (size_t)((t) * 64 + 32) * 3072); \
    rv[0] = *(const u32x4*)(vg + (t) * 64); rv[1] = *(const u32x4*)(vg + (size_t)32 * SEQ + (t) * 64); \
    if (gt < 64) { const int j_ = (t) * 64 + gt; rbias = (fend - fl[j_] + suf[j_ >> 7]) * LOG2E; } } while (0)
#define AT_STORE(st) do { \
    *(u32x4*)(smem + (st) + AT_K + sk_) = rk[0]; *(u32x4*)(smem + (st) + AT_K + sk_ + 32 * LROW) = rk[1]; \
    *(u32x4*)(smem + (st) + AT_V + sk_) = rv[0]; *(u32x4*)(smem + (st) + AT_V + sk_ + 32 * LROW) = rv[1]; \
    if (gt < 64) *(float*)(smem + (st) + AT_BIAS + gt * 4) = rbias; } while (0)
  AT_LOAD(0);
  AT_STORE(gbase);
  __syncthreads();
  float m = -INFINITY, l = 0.f;
  f32x16 o[2];
#pragma unroll
  for (int r = 0; r < 16; ++r) { o[0][r] = 0.f; o[1][r] = 0.f; }
#pragma nounroll
  for (int t = 0; t < NT; ++t) {
    const int st = gbase + (t & 1) * AT_STG;
    const bool more = t + 1 < NT;
    if (more) AT_LOAD(t + 1);
    const bool active = !(t == 2 * qb + 1 && wq < 2);
    if (active) {
      f32x16 s0, s1;
#pragma unroll
      for (int r = 0; r < 16; ++r) { s0[r] = 0.f; s1[r] = 0.f; }
#pragma unroll
      for (int d0 = 0; d0 < 4; ++d0) {
        const bf16x8 k0 = *(const bf16x8*)(smem + st + AT_K + l32 * LROW + d0 * 32 + hi * 16);
        const bf16x8 k1 = *(const bf16x8*)(smem + st + AT_K + (32 + l32) * LROW + d0 * 32 + hi * 16);
        s0 = __builtin_amdgcn_mfma_f32_32x32x16_bf16(k0, qf[d0], s0, 0, 0, 0);
        s1 = __builtin_amdgcn_mfma_f32_32x32x16_bf16(k1, qf[d0], s1, 0, 0, 0);
      }
#pragma unroll
      for (int rq = 0; rq < 4; ++rq) {
        const f32x4 b0 = *(const f32x4*)(smem + st + AT_BIAS + (8 * rq + 4 * hi) * 4);
        const f32x4 b1 = *(const f32x4*)(smem + st + AT_BIAS + (32 + 8 * rq + 4 * hi) * 4);
#pragma unroll
        for (int e = 0; e < 4; ++e) { s0[4 * rq + e] += b0[e]; s1[4 * rq + e] += b1[e]; }
      }
      if (t >= 2 * qb) {
        const int kb = 64 * (t - 2 * qb), qrel = 32 * wq + l32;
#pragma unroll
        for (int r = 0; r < 16; ++r) {
          const int kv = kb + crow(r, hi);
          if (kv > qrel) s0[r] = -INFINITY;
          if (kv + 32 > qrel) s1[r] = -INFINITY;
        }
      }
      float mx = s0[0];
#pragma unroll
      for (int r = 1; r < 16; ++r) mx = fmaxf(mx, s0[r]);
#pragma unroll
      for (int r = 0; r < 16; ++r) mx = fmaxf(mx, s1[r]);
      mx = fmaxf(mx, __shfl_xor(mx, 32));
      const float mn = fmaxf(m, mx);
      const float alpha = __builtin_amdgcn_exp2f(m - mn);
      m = mn;
      float ls = 0.f;
#pragma unroll
      for (int r = 0; r < 16; ++r) { s0[r] = __builtin_amdgcn_exp2f(s0[r] - mn); s1[r] = __builtin_amdgcn_exp2f(s1[r] - mn); ls += s0[r] + s1[r]; }
      l = l * alpha + ls;
#pragma unroll
      for (int r = 0; r < 16; ++r) { o[0][r] *= alpha; o[1][r] *= alpha; }
      bf16x8 pf[2][2];
#pragma unroll
      for (int ks = 0; ks < 2; ++ks) {
        u32x4 a, c;
        a[0] = pk2(s0[8 * ks + 0], s0[8 * ks + 1]); a[1] = pk2(s0[8 * ks + 2], s0[8 * ks + 3]); a[2] = pk2(s0[8 * ks + 4], s0[8 * ks + 5]); a[3] = pk2(s0[8 * ks + 6], s0[8 * ks + 7]);
        c[0] = pk2(s1[8 * ks + 0], s1[8 * ks + 1]); c[1] = pk2(s1[8 * ks + 2], s1[8 * ks + 3]); c[2] = pk2(s1[8 * ks + 4], s1[8 * ks + 5]); c[3] = pk2(s1[8 * ks + 6], s1[8 * ks + 7]);
        pf[0][ks] = __builtin_bit_cast(bf16x8, a); pf[1][ks] = __builtin_bit_cast(bf16x8, c);
      }
#pragma unroll
      for (int pbk = 0; pbk < 2; ++pbk)
#pragma unroll
        for (int ks = 0; ks < 2; ++ks)
#pragma unroll
          for (int db = 0; db < 2; ++db) {
            const int off = st + AT_V + (32 * db + l32) * LROW + (32 * pbk + 16 * ks + 4 * hi) * 2;
            const u32x2 lo = *(const u32x2*)(smem + off), hh = *(const u32x2*)(smem + off + 16);
            u32x4 vv; vv[0] = lo[0]; vv[1] = lo[1]; vv[2] = hh[0]; vv[3] = hh[1];
            o[db] = __builtin_amdgcn_mfma_f32_32x32x16_bf16(__builtin_bit_cast(bf16x8, vv), pf[pbk][ks], o[db], 0, 0, 0);
          }
    }
    if (more) AT_STORE(gbase + ((t + 1) & 1) * AT_STG);
    __syncthreads();
  }
#undef AT_LOAD
#undef AT_STORE
  l += __shfl_xor(l, 32);
  const float inv = 1.f / l;
#pragma unroll
  for (int db = 0; db < 2; ++db)
#pragma unroll
    for (int rq = 0; rq < 4; ++rq) {
      u32x2 ov; ov[0] = pk2(o[db][4 * rq] * inv, o[db][4 * rq + 1] * inv); ov[1] = pk2(o[db][4 * rq + 2] * inv, o[db][4 * rq + 3] * inv);
      *(u32x2*)(ycat + (size_t)tokq * DM + 512 + h * 64 + 32 * db + 8 * rq + 4 * hi) = ov;
    }
}
DEV void conv_mixer(const Params& P, int p) {
  const int c = tid_l(), m0 = p * 128, s0 = m0 % SEQ;
  const bf16_t* z = (const bf16_t*)(P.ws + WS_Z);
  bf16_t* ycat = (bf16_t*)(P.ws + WS_HN);
  const float w0 = P.even_conv_w[c], w1 = P.even_conv_w[512 + c], w2 = P.even_conv_w[1024 + c];
  float g2 = 0.f, g1 = 0.f;
  if (s0 > 0) {
    const bf16_t* r2 = z + (size_t)(m0 - 2) * 3072, *r1 = z + (size_t)(m0 - 1) * 3072;
    g2 = bf2f(r2[512 + c]) * bf2f(r2[1024 + c]); g1 = bf2f(r1[512 + c]) * bf2f(r1[1024 + c]);
  }
  for (int t = 0; t < 128; ++t) {
    const bf16_t* r = z + (size_t)(m0 + t) * 3072;
    const float g0 = bf2f(r[512 + c]) * bf2f(r[1024 + c]);
    const float y = bf2f(r[c]) * (w0 * g2 + w1 * g1 + w2 * g0);
    ycat[(size_t)(m0 + t) * DM + c] = f2bf(y);
    g2 = g1; g1 = g0;
  }
}

DEV unsigned fkey(float x) { const unsigned u = __float_as_uint(x); return (u & 0x80000000u) ? ~u : (u | 0x80000000u); }
DEV float keyf(unsigned k) { const unsigned u = (k & 0x80000000u) ? (k & 0x7fffffffu) : ~k; return __uint_as_float(u); }
DEV void ins16(unsigned (&L)[16], unsigned key) {
#pragma unroll
  for (int j = 0; j < 16; ++j) { const unsigned a = L[j]; L[j] = max(a, key); key = min(a, key); }
}
DEV void stage1(unsigned (&L)[16], const float* sp) {
#pragma unroll
  for (int j = 0; j < 16; ++j) L[j] = 0u;
#pragma nounroll
  for (int i = 0; i < 128; i += 8) {
    float v[8];
#pragma unroll
    for (int e = 0; e < 8; ++e) v[e] = sp[(size_t)(i + e) * 128];
#pragma unroll
    for (int e = 0; e < 8; ++e) ins16(L, (fkey(v[e]) & ~127u) | (unsigned)(127 - (i + e)));
  }
}
DEV void topk_group(int hg, const float* scoresT, int* idxo, float* go) {
  const int tid = tid_l(), token = tid & 127, hl = tid >> 7;
  unsigned LA[16], LB[16], LC[16];
  stage1(LA, scoresT + (size_t)(hl * 256) * 128 + token);
  stage1(LB, scoresT + (size_t)(hl * 256 + 128) * 128 + token);
  unsigned* la = (unsigned*)smem; unsigned* lb = la + 16 * 512;
  float bv[16];
#pragma unroll
  for (int j = 0; j < 16; ++j) { LC[j] = 0u; bv[j] = keyf(LB[j] & ~127u); la[j * 512 + tid] = LA[j]; lb[j * 512 + tid] = LB[j]; }
#pragma unroll
  for (int i = 0; i < 16; ++i) {
    const float av = keyf(LA[i] & ~127u);
#pragma unroll
    for (int j = 0; j < 16; ++j)
      if ((i + 1) * (j + 1) <= 16) ins16(LC, (fkey(av + bv[j]) & ~255u) | (unsigned)(255 - (i * 16 + j)));
  }
  const float smax = keyf(LC[0] & ~255u);
  float ev[16], sum = 0.f;
#pragma unroll
  for (int k = 0; k < 16; ++k) { ev[k] = __expf(keyf(LC[k] & ~255u) - smax); sum += ev[k]; }
  const float inv = 1.f / sum;
  const int head = hg * 4 + hl;
#pragma unroll
  for (int k = 0; k < 16; ++k) {
    const int c = 255 - (int)(LC[k] & 255u), i = c >> 4, j = c & 15;
    const int i1 = 127 - (int)(la[i * 512 + tid] & 127u), i2 = 127 - (int)(lb[j * 512 + tid] & 127u);
    idxo[token * 128 + head * 16 + k] = i1 * 128 + i2;
    go[token * 128 + head * 16 + k] = ev[k] * inv;
  }
}
DEV float sw32sum(float a, float b) { auto r = __builtin_amdgcn_permlane32_swap(__float_as_uint(a), __float_as_uint(b), false, false); return __uint_as_float(r[0]) + __uint_as_float(r[1]); }
DEV float sw16sum(float a, float b) { auto r = __builtin_amdgcn_permlane16_swap(__float_as_uint(a), __float_as_uint(b), false, false); return __uint_as_float(r[0]) + __uint_as_float(r[1]); }
template <int N> DEV float row_ror_add(float v) { return v + __uint_as_float((unsigned)__builtin_amdgcn_update_dpp(0, (int)__float_as_uint(v), 0x120 + N, 0xf, 0xf, false)); }
DEV float row_allsum(float v) { v = row_ror_add<8>(v); v = row_ror_add<4>(v); v = row_ror_add<2>(v); v = row_ror_add<1>(v); return v; }
DEV f32x2_t fp8x2(unsigned d, bool hiw) { return hiw ? __builtin_amdgcn_cvt_pk_f32_fp8((int)d, true) : __builtin_amdgcn_cvt_pk_f32_fp8((int)d, false); }
constexpr float TAB_SCALE = 64.f, TAB_INV = 1.f / 64.f;
DEV void peer_gather(const Params& P, int l, int m0, const int* idxs, const float* gs) {
  const int tid = tid_l(), lane = tid & 63, wid = tid >> 6;
  const unsigned char* U = P.ws + WS_TAB + (size_t)l * 32 * MB;
  const unsigned char* V = U + 16 * MB;
  bf16_t* hn = (bf16_t*)(P.ws + WS_HN);
  const float* gp = P.norm_ple + l * DM;
  const int row = lane >> 4, rmap = ((row & 1) << 1) | (row >> 1);
#pragma nounroll
  for (int i = 0; i < 16; ++i) {
    const int tt = wid * 16 + i; const size_t tok = (size_t)(m0 + tt);
    const u32x4 xa = *(const u32x4*)(hn + tok * DM + lane * 16), xb = *(const u32x4*)(hn + tok * DM + lane * 16 + 8);
    f32x2_t xp[8];
#pragma unroll
    for (int q = 0; q < 4; ++q) { xp[q] = (f32x2_t){bflo(xa[q]), bfhi(xa[q])}; xp[4 + q] = (f32x2_t){bflo(xb[q]), bfhi(xb[q])}; }
    const int myi0 = idxs[tt * 128 + lane], myi1 = idxs[tt * 128 + 64 + lane];
    f32x2_t acc[8];
#pragma unroll
    for (int q = 0; q < 8; ++q) acc[q] = (f32x2_t){0.f, 0.f};
    u32x4 ub0[8], vb0[8], ub1[8], vb1[8];
#define PG_ISSUE(UB, VB, e0_) do { const int isrc_ = ((e0_) < 64) ? myi0 : myi1; \
      _Pragma("unroll") for (int e = 0; e < 8; ++e) { const int idx_ = __builtin_amdgcn_readlane(isrc_, ((e0_) + e) & 63); \
        UB[e] = *(const u32x4*)(U + (size_t)idx_ * 1024 + lane * 16); VB[e] = *(const u32x4*)(V + (size_t)idx_ * 1024 + lane * 16); } } while (0)
#define PG_COMPUTE(UB, VB, e0_) do { float d_[8]; \
      _Pragma("unroll") for (int e = 0; e < 8; ++e) { f32x2_t s_ = {0.f, 0.f}; \
        _Pragma("unroll") for (int q = 0; q < 4; ++q) { s_ = __builtin_elementwise_fma(xp[2 * q], fp8x2(UB[e][q], false), s_); s_ = __builtin_elementwise_fma(xp[2 * q + 1], fp8x2(UB[e][q], true), s_); } \
        d_[e] = s_[0] + s_[1]; } \
      float s0_ = sw16sum(sw32sum(d_[0], d_[1]), sw32sum(d_[2], d_[3])); \
      float s1_ = sw16sum(sw32sum(d_[4], d_[5]), sw32sum(d_[6], d_[7])); \
      s0_ = row_allsum(s0_) * TAB_INV; s1_ = row_allsum(s1_) * TAB_INV; \
      const float w0_ = gs[tt * 128 + (e0_) + rmap] * gelu_tanh(s0_), w1_ = gs[tt * 128 + (e0_) + 4 + rmap] * gelu_tanh(s1_); \
      _Pragma("unroll") for (int e = 0; e < 8; ++e) { const int rw_ = (((e & 1) << 1) | ((e >> 1) & 1)) * 16; \
        const float we_ = __uint_as_float(__builtin_amdgcn_readlane(__float_as_uint((e < 4) ? w0_ : w1_), rw_)); const f32x2_t w2_ = {we_, we_}; \
        _Pragma("unroll") for (int q = 0; q < 4; ++q) { acc[2 * q] = __builtin_elementwise_fma(w2_, fp8x2(VB[e][q], false), acc[2 * q]); acc[2 * q + 1] = __builtin_elementwise_fma(w2_, fp8x2(VB[e][q], true), acc[2 * q + 1]); } } } while (0)
    PG_ISSUE(ub0, vb0, 0);
#pragma nounroll
    for (int e0 = 0; e0 < 128; e0 += 16) {
      PG_ISSUE(ub1, vb1, e0 + 8);
      PG_COMPUTE(ub0, vb0, e0);
      if (e0 + 16 < 128) PG_ISSUE(ub0, vb0, e0 + 16);
      PG_COMPUTE(ub1, vb1, e0 + 8);
    }
#undef PG_ISSUE
#undef PG_COMPUTE
    float* hrow = P.out + tok * DM + lane * 16;
    f32x4 hv[4]; float ss = 0.f;
#pragma unroll
    for (int q = 0; q < 4; ++q) hv[q] = *(const f32x4*)(hrow + 4 * q);
#pragma unroll
    for (int q = 0; q < 4; ++q) {
      hv[q][0] += acc[2 * q][0] * TAB_INV; hv[q][1] += acc[2 * q][1] * TAB_INV; hv[q][2] += acc[2 * q + 1][0] * TAB_INV; hv[q][3] += acc[2 * q + 1][1] * TAB_INV;
      ss += hv[q][0] * hv[q][0] + hv[q][1] * hv[q][1] + hv[q][2] * hv[q][2] + hv[q][3] * hv[q][3];
      *(f32x4*)(hrow + 4 * q) = hv[q];
    }
    const float rstd = rsqrtf(wave_sum(ss) * (1.f / DM) + EPS);
    u32x4 oa, ob;
#pragma unroll
    for (int q = 0; q < 4; ++q) {
      const f32x4 g = *(const f32x4*)(gp + lane * 16 + 4 * q);
      const unsigned p0 = pk2(hv[q][0] * rstd * g[0], hv[q][1] * rstd * g[1]), p1 = pk2(hv[q][2] * rstd * g[2], hv[q][3] * rstd * g[3]);
      if (q < 2) { oa[2 * q] = p0; oa[2 * q + 1] = p1; } else { ob[2 * (q - 2)] = p0; ob[2 * (q - 2) + 1] = p1; }
    }
    *(u32x4*)(hn + tok * DM + lane * 16) = oa; *(u32x4*)(hn + tok * DM + lane * 16 + 8) = ob;
  }
}
DEV void resid_gemm(const Params& P, int m0, const bf16_t* A, const bf16_t* Wt, const float* base) {
  GEO
#pragma nounroll
  for (int nt = 0; nt < 4; ++nt) {
    f32x16 acc[2][2]; acc_zero(acc);
    gemm_kloop(acc, A + (size_t)m0 * DM, DM, Wt + (size_t)nt * 256 * DM, DM, DM);
    epi_resid_f32(acc, base, P.out, m0, nt * 256);
  }
}
DEV void chain_peer_ple(const Params& P, int l, int p) {
  GEO
  const int m0 = p * 128;
  bf16_t* hn = (bf16_t*)(P.ws + WS_HN);
  unsigned char* slice = P.ws + WS_Z + (size_t)p * SLICE;
  float* scoresT = (float*)slice; int* idxs = (int*)(slice + 512 * 1024); float* gs = (float*)(slice + 576 * 1024);
  __syncthreads();
  panel_rmsnorm(P.out, P.norm_ffn + l * DM, hn, m0);
  const bf16_t* wpt = (const bf16_t*)(P.ws + W_PT) + (size_t)l * 2048 * 1024;
#pragma nounroll
  for (int hg = 0; hg < 2; ++hg) {
#pragma nounroll
  for (int nt = 0; nt < 4; ++nt) {
      f32x16 acc[2][2]; acc_zero(acc);
      gemm_kloop(acc, hn + (size_t)m0 * DM, DM, wpt + (size_t)((hg * 4 + nt) * 256) * DM, DM, DM);
      FOR_ACC {
        const int tr = 64 * wm + 32 * mb + l32, col = nt * 256 + 64 * wn + 32 * nb + 8 * rq + 4 * hi;
#pragma unroll
        for (int e = 0; e < 4; ++e) scoresT[(size_t)(col + e) * 128 + tr] = acc[nb][mb][4 * rq + e];
      }
    }
    __syncthreads();
    topk_group(hg, scoresT, idxs, gs);
    __syncthreads();
  }
  peer_gather(P, l, m0, idxs, gs);
  __syncthreads();
  const bf16_t* wg = (const bf16_t*)(P.ws + W_GATE) + (size_t)l * 1024 * 1024;
  const bf16_t* wu = (const bf16_t*)(P.ws + W_UP) + (size_t)l * 1024 * 256;
  const bf16_t* pb = (const bf16_t*)(P.ws + WS_PB) + ((size_t)l * T_TOK + m0) * 256;
#pragma nounroll
  for (int nt = 0; nt < 4; ++nt) {
    unsigned sg[2][2][8];
    {
      f32x16 ag[2][2]; acc_zero(ag);
      gemm_kloop(ag, hn + (size_t)m0 * DM, DM, wg + (size_t)nt * 256 * DM, DM, DM);
#pragma unroll
      for (int nb = 0; nb < 2; ++nb)
#pragma unroll
        for (int mb = 0; mb < 2; ++mb)
#pragma unroll
          for (int q = 0; q < 8; ++q) sg[nb][mb][q] = pk2(sigmoidf_(ag[nb][mb][2 * q]), sigmoidf_(ag[nb][mb][2 * q + 1]));
    }
    f32x16 au[2][2]; acc_zero(au);
    gemm_kloop(au, pb, 256, wu + (size_t)nt * 256 * 256, 256, 256);
#pragma unroll
    for (int nb = 0; nb < 2; ++nb)
#pragma unroll
      for (int mb = 0; mb < 2; ++mb)
#pragma unroll
        for (int q = 0; q < 8; ++q) { au[nb][mb][2 * q] *= bflo(sg[nb][mb][q]); au[nb][mb][2 * q + 1] *= bfhi(sg[nb][mb][q]); }
    epi_resid_f32(au, P.out, P.out, m0, nt * 256);
  }
  __syncthreads();
}

DEV void l1_inproj(const Params& P, int p) {
  GEO
  const int m0 = p * 128;
  bf16_t* hn = (bf16_t*)(P.ws + WS_HN);
  bf16_t* zz = (bf16_t*)(P.ws + WS_Z + (size_t)p * SLICE);
  panel_rmsnorm(P.out, P.norm_mix + DM, hn, m0);
  const bf16_t* wt = (const bf16_t*)(P.ws + W_IN1);
#pragma nounroll
  for (int nt = 0; nt < 8; ++nt) {
    f32x16 acc[2][2]; acc_zero(acc);
    gemm_kloop(acc, hn + (size_t)m0 * DM, DM, wt + (size_t)nt * 256 * DM, DM, DM);
    epi_rows_bf16(acc, [&](int tr, int cr, u32x4 v) { *(u32x4*)(zz + (size_t)tr * 2048 + nt * 256 + cr) = v; });
  }
}
DEV void p4_panel(const Params& P, int p) {
  GEO
  const int m0 = p * 128, s0 = m0 % SEQ;
  bf16_t* xrc = (bf16_t*)(P.ws + WS_HN);
  const bf16_t* zz = (const bf16_t*)(P.ws + WS_Z + (size_t)p * SLICE);
  const bf16_t* zzp = (const bf16_t*)(P.ws + WS_Z + (size_t)(p - 1) * SLICE);
  bf16_t* la = (bf16_t*)(P.ws + WS_TAB + 64 * MB);
  bf16_t* ub = (bf16_t*)(P.ws + WS_Z + (size_t)p * SLICE + 512 * 1024);
  __syncthreads();
#pragma unroll
  for (int q = 0; q < 2; ++q) {
    const int ch = tid + q * 512;
    const float w0 = P.odd_conv_w[ch], w1 = P.odd_conv_w[1024 + ch], w2 = P.odd_conv_w[2048 + ch], w3 = P.odd_conv_w[3072 + ch], cb = P.odd_conv_b[ch];
    float x3 = 0.f, x2 = 0.f, x1 = 0.f;
    if (s0 > 0) { x3 = bf2f(zzp[(size_t)125 * 2048 + 1024 + ch]); x2 = bf2f(zzp[(size_t)126 * 2048 + 1024 + ch]); x1 = bf2f(zzp[(size_t)127 * 2048 + 1024 + ch]); }
    for (int t = 0; t < 128; ++t) {
      const float x0 = bf2f(zz[(size_t)t * 2048 + 1024 + ch]);
      xrc[(size_t)(m0 + t) * DM + ch] = f2bf(w0 * x3 + w1 * x2 + w2 * x1 + w3 * x0 + cb);
      x3 = x2; x2 = x1; x1 = x0;
    }
  }
  __syncthreads();
  const bf16_t* wax = (const bf16_t*)(P.ws + W_AX);
#pragma nounroll
  for (int h = 0; h < 8; ++h) {
    f32x16 acc[2][2]; acc_zero(acc);
    gemm_kloop(acc, xrc + (size_t)m0 * DM + h * 128, DM, wax + (size_t)h * 256 * 128, 128, 128);
#pragma unroll
    for (int rq = 0; rq < 4; ++rq) {
      const int ch = h * 128 + 32 * wn + 8 * rq + 4 * hi;
      const f32x4 ba = *(const f32x4*)(P.odd_b_a + ch), bx = *(const f32x4*)(P.odd_b_x + ch), lp = *(const f32x4*)(P.odd_lru + ch);
      float sp[4];
#pragma unroll
      for (int e = 0; e < 4; ++e) { const float nl = -lp[e]; sp[e] = fmaxf(nl, 0.f) + log1pf(__expf(-fabsf(nl))); }
#pragma unroll
      for (int mb = 0; mb < 2; ++mb) {
        const int tr = 64 * wm + 32 * mb + l32; const size_t tok = (size_t)(m0 + tr);
        const u32x2 xr = *(const u32x2*)(xrc + tok * DM + ch);
        const float xv[4] = {bflo(xr[0]), bfhi(xr[0]), bflo(xr[1]), bfhi(xr[1])};
        float lav[4], uv[4];
#pragma unroll
        for (int e = 0; e < 4; ++e) {
          const float rg = sigmoidf_(acc[0][mb][4 * rq + e] + ba[e]), ig = sigmoidf_(acc[1][mb][4 * rq + e] + bx[e]);
          lav[e] = -8.f * rg * sp[e];
          uv[e] = sqrtf(-expm1f(2.f * lav[e])) * (ig * xv[e]);
        }
        u32x2 o1, o2; o1[0] = pk2(lav[0], lav[1]); o1[1] = pk2(lav[2], lav[3]); o2[0] = pk2(uv[0], uv[1]); o2[1] = pk2(uv[2], uv[3]);
        *(u32x2*)(la + tok * DM + ch) = o1;
        *(u32x2*)(ub + (size_t)tr * DM + ch) = o2;
      }
    }
  }
  __syncthreads();
  float* aprod = (float*)(P.ws + WS_APROD); float* hend = (float*)(P.ws + WS_HEND);
#pragma unroll
  for (int q = 0; q < 2; ++q) {
    const int ch = tid + q * 512;
    float Asum = 0.f, H = 0.f;
    for (int t = 0; t < 128; ++t) {
      const float lv = bf2f(la[(size_t)(m0 + t) * DM + ch]), u = bf2f(ub[(size_t)t * DM + ch]);
      H = __expf(lv) * H + u; Asum += lv;
    }
    aprod[p * DM + ch] = __expf(Asum); hend[p * DM + ch] = H;
  }
}
DEV void p5_pre(const Params& P, int p) {
  GEO
  const int m0 = p * 128;
  const int pfirst = (p >> 7) << 7;
  const float* aprod = (const float*)(P.ws + WS_APROD); const float* hend = (const float*)(P.ws + WS_HEND);
  const bf16_t* la = (const bf16_t*)(P.ws + WS_TAB + 64 * MB);
  const bf16_t* ub = (const bf16_t*)(P.ws + WS_Z + (size_t)p * SLICE + 512 * 1024);
  const bf16_t* zz = (const bf16_t*)(P.ws + WS_Z + (size_t)p * SLICE);
  bf16_t* y = (bf16_t*)(P.ws + WS_HN);
  __syncthreads();
#pragma unroll
  for (int q = 0; q < 2; ++q) {
    const int ch = tid + q * 512;
    float H = 0.f;
#pragma unroll 8
    for (int pp = pfirst; pp < p; ++pp) H = aprod[pp * DM + ch] * H + hend[pp * DM + ch];
    for (int t = 0; t < 128; ++t) {
      const float lv = bf2f(la[(size_t)(m0 + t) * DM + ch]), u = bf2f(ub[(size_t)t * DM + ch]);
      H = __expf(lv) * H + u;
      const float gt_ = bf2f(zz[(size_t)t * 2048 + ch]);
      y[(size_t)(m0 + t) * DM + ch] = f2bf(H * gelu_tanh(gt_));
    }
  }
  __syncthreads();
}

__global__ void __launch_bounds__(512) mega(Params P) {
  cg::grid_group grid = cg::this_grid();
  const int tid = threadIdx.x;
  unsigned char* ws = P.ws;
  transpose_job(P.even_w_in, 1024, 3072, 3080, (bf16_t*)(ws + W_IN0), 1024);
  transpose_job(P.even_w_out, 1024, 1024, 1024, (bf16_t*)(ws + W_OUT0), 1024);
  transpose_job(P.odd_w_in, 1024, 2048, 2048, (bf16_t*)(ws + W_IN1), 1024);
  transpose_job(P.odd_w_out, 1024, 1024, 1024, (bf16_t*)(ws + W_OUT1), 1024);
#pragma nounroll
  for (int l = 0; l < 2; ++l) {
    transpose_job(P.ple_up + (size_t)l * 256 * 1024, 256, 1024, 1024, (bf16_t*)(ws + W_UP) + (size_t)l * 1024 * 256, 256);
    transpose_job(P.ple_gate + (size_t)l * 1024 * 1024, 1024, 1024, 1024, (bf16_t*)(ws + W_GATE) + (size_t)l * 1024 * 1024, 1024);
  }
  convert_job(P.peer_wq, (bf16_t*)(ws + W_QB), (size_t)2 * 1024 * 2048);
  convert_job(P.p, (bf16_t*)(ws + WS_PB), (size_t)2 * T_TOK * 256);
#pragma nounroll
  for (int l = 0; l < 2; ++l) {
    convert_fp8_job(P.peer_u + (size_t)l * 16384 * 1024, ws + WS_TAB + (size_t)(2 * l) * 16 * MB, (size_t)16384 * 1024);
    convert_fp8_job(P.peer_v + (size_t)l * 16384 * 1024, ws + WS_TAB + (size_t)(2 * l + 1) * 16 * MB, (size_t)16384 * 1024);
  }
  {
    const int gsz = gridDim.x * 512, gid = blockIdx.x * 512 + tid;
    bf16_t* bsk = (bf16_t*)(ws + W_SK);
    for (int i = gid; i < 2 * 65536; i += gsz) {
      const int l = i >> 16, n = (i >> 8) & 255, k = i & 255;
      float v = 0.f;
      if ((n < 128) == (k < 128)) v = P.peer_sk[(size_t)l * 32768 + (size_t)(n >> 7) * 16384 + (n & 127) * 128 + (k & 127)];
      bsk[i] = f2bf(v);
    }
    bf16_t* wax = (bf16_t*)(ws + W_AX);
    for (int i = gid; i < 8 * 256 * 128; i += gsz) {
      const int h = i >> 15, n = (i >> 7) & 255, k = i & 127;
      const int wn = n >> 6, nb = (n >> 5) & 1, jj = n & 31;
      const float* src = nb ? P.odd_w_x : P.odd_w_a;
      wax[i] = f2bf(src[(size_t)h * 16384 + k * 128 + 32 * wn + jj]);
    }
  }
  grid.sync();
#pragma nounroll
  for (int p = blockIdx.x; p < NPANEL; p += gridDim.x) { asm volatile("" ::: "memory"); p1_panel(P, p); }
#pragma nounroll
  for (int u = blockIdx.x; u < 128; u += gridDim.x) { asm volatile("" ::: "memory"); fold_unit(P, u); }
  grid.sync();
#pragma nounroll
  for (int blk = blockIdx.x; blk < 256; blk += gridDim.x) {
    asm volatile("" ::: "memory");
    const int bh = blk & 7, s = blk >> 3, b = bh >> 2, hp = bh & 3;
    attn_unit(P, b, 127 - s, hp);
    attn_unit(P, b, 64 + s, hp);
    attn_unit(P, b, 63 - s, hp);
    attn_unit(P, b, s, hp);
  }
#pragma nounroll
  for (int p = blockIdx.x; p < NPANEL; p += gridDim.x) { asm volatile("" ::: "memory"); conv_mixer(P, p); }
  grid.sync();
#pragma nounroll
  for (int p = blockIdx.x; p < NPANEL; p += gridDim.x) {
    Params Q = P; asm volatile("" : "+s"(Q.ws), "+s"(Q.out) :: "memory");
    resid_gemm(Q, p * 128, (const bf16_t*)(Q.ws + WS_HN), (const bf16_t*)(Q.ws + W_OUT0), Q.x);
    chain_peer_ple(Q, 0, p);
    l1_inproj(Q, p);
  }
  grid.sync();
#pragma nounroll
  for (int p = blockIdx.x; p < NPANEL; p += gridDim.x) { asm volatile("" ::: "memory"); p4_panel(P, p); }
  grid.sync();
#pragma nounroll
  for (int p = blockIdx.x; p < NPANEL; p += gridDim.x) {
    Params Q = P; asm volatile("" : "+s"(Q.ws), "+s"(Q.out) :: "memory");
    p5_pre(Q, p);
    resid_gemm(Q, p * 128, (const bf16_t*)(Q.ws + WS_HN), (const bf16_t*)(Q.ws + W_OUT1), Q.out);
    chain_peer_ple(Q, 1, p);
  }
}

extern "C" void kernel_launch(void* const* d_in, const int* in_sizes, int n_in, void* d_out, int out_size, void* d_ws, size_t ws_size, hipStream_t stream) {
  static int grid_blocks = 0;
  if (grid_blocks == 0) {
    if (n_in != 26 || ws_size < WS_END) { fprintf(stderr, "kernel_launch: unexpected n_in %d / ws_size %zu\n", n_in, ws_size); grid_blocks = -1; return; }
    int dev = 0, cus = 0, per_cu = 0;
    (void)hipGetDevice(&dev);
    (void)hipDeviceGetAttribute(&cus, hipDeviceAttributeMultiprocessorCount, dev);
    (void)hipFuncSetAttribute((const void*)mega, hipFuncAttributeMaxDynamicSharedMemorySize, LDS_BYTES);
    (void)hipOccupancyMaxActiveBlocksPerMultiprocessor(&per_cu, (const void*)mega, 512, LDS_BYTES);
    if (per_cu < 1) { fprintf(stderr, "kernel_launch: occupancy query reports 0 blocks per CU\n"); grid_blocks = -1; return; }
    grid_blocks = cus;
    if (grid_blocks > 256) grid_blocks = 256;
  }
  if (grid_blocks < 0) return;
  Params P{};
  const float** pp = (const float**)&P;
  for (int i = 0; i < 26; ++i) pp[i] = (const float*)d_in[i];
  P.out = (float*)d_out; P.ws = (unsigned char*)d_ws;
  void* args[] = {&P};
  hipError_t e = hipLaunchCooperativeKernel((const void*)mega, dim3(grid_blocks), dim3(512), args, LDS_BYTES, stream);
  if (e != hipSuccess) fprintf(stderr, "cooperative launch failed: %s (grid %d)\n", hipGetErrorString(e), grid_blocks);
}
```

```cpp
#include <hip/hip_runtime.h>
#include <hip/hip_cooperative_groups.h>
#include <stdint.h>
#include <cstdio>
namespace cg = cooperative_groups;

typedef unsigned short bf16_t;
typedef short bf16x8 __attribute__((ext_vector_type(8)));
typedef float f32x16 __attribute__((ext_vector_type(16)));
typedef float f32x4 __attribute__((ext_vector_type(4)));
typedef unsigned u32x4 __attribute__((ext_vector_type(4)));
typedef unsigned u32x2 __attribute__((ext_vector_type(2)));
typedef float f32x2_t __attribute__((ext_vector_type(2)));
typedef __bf16 bf16x2_t __attribute__((ext_vector_type(2)));
#define DEV __device__ __forceinline__

constexpr int T_TOK = 32768, SEQ = 16384, DM = 1024, NPANEL = 256;
constexpr float EPS = 1e-6f, LOG2E = 1.4426950408889634f;
constexpr size_t MB = 1u << 20;
constexpr size_t WS_FLOC = 0;
constexpr size_t WS_PTOT = 1 * MB;
constexpr size_t WS_APROD = 2 * MB;
constexpr size_t WS_HEND = 3 * MB;
constexpr size_t WS_W = 4 * MB;
constexpr size_t W_IN0 = WS_W, W_OUT0 = WS_W + 6 * MB, W_IN1 = WS_W + 8 * MB, W_AX = WS_W + 12 * MB, W_OUT1 = WS_W + 13 * MB,
                 W_QB = WS_W + 15 * MB, W_SK = WS_W + 23 * MB, W_PT = WS_W + 24 * MB, W_UP = WS_W + 32 * MB, W_GATE = WS_W + 33 * MB;
constexpr size_t WS_TAB = 44 * MB;
constexpr size_t WS_PB = 172 * MB;
constexpr size_t WS_HN = 204 * MB;
constexpr size_t WS_Z = 268 * MB;
constexpr size_t WS_VT = 460 * MB;
constexpr size_t WS_END = 492 * MB;
constexpr size_t SLICE = 768 * 1024;

constexpr int LROW = 144;
constexpr int GS_A = 0, GS_B = 16384, GS_STAGE = 49152;
constexpr int LDS_MISC = 3 * GS_STAGE;
constexpr int LDS_BYTES = 163840;
typedef __attribute__((address_space(3))) unsigned lds_u32;

extern __shared__ __attribute__((aligned(16))) unsigned char smem[];
#ifdef PROBE_TS
__device__ unsigned long long g_ts[32];
#define STAMP(k) do { if (blockIdx.x == 0 && threadIdx.x == 0) g_ts[k] = __builtin_amdgcn_s_memrealtime(); } while (0)
#else
#define STAMP(k) do {} while (0)
#endif


struct Params {
  const float *x, *p, *norm_mix, *norm_ffn, *norm_ple, *even_w_in, *even_b_forget, *even_conv_w, *even_q_gain, *even_k_gain, *even_w_out,
      *odd_w_in, *odd_conv_w, *odd_conv_b, *odd_w_a, *odd_b_a, *odd_w_x, *odd_b_x, *odd_lru, *odd_w_out,
      *peer_wq, *peer_sk, *peer_u, *peer_v, *ple_up, *ple_gate;
  float* out; unsigned char* ws;
};

DEV unsigned pk2(float lo, float hi) { f32x2_t v = {lo, hi}; bf16x2_t b = __builtin_convertvector(v, bf16x2_t); return __builtin_bit_cast(unsigned, b); }
DEV float bflo(unsigned u) { return __uint_as_float(u << 16); }
DEV float bfhi(unsigned u) { return __uint_as_float(u & 0xffff0000u); }
DEV float bf2f(bf16_t v) { return __uint_as_float((unsigned)v << 16); }
DEV bf16_t f2bf(float f) { return (bf16_t)(pk2(f, 0.f) & 0xffffu); }
DEV int tid_l() { int t = threadIdx.x; asm volatile("" : "+v"(t)); return t; }
DEV float wave_sum(float v) {
#pragma unroll
  for (int o = 1; o < 64; o <<= 1) v += __shfl_xor(v, o);
  return v;
}
DEV float gelu_tanh(float x) { const float u = 1.5957691216057308f * (x + 0.044715f * x * x * x); return x * __builtin_amdgcn_rcpf(1.f + __expf(-u)); }
DEV float sigmoidf_(float x) { return __builtin_amdgcn_rcpf(1.f + __expf(-x)); }
DEV float neg_expm1(float x) {
  const float pl = -x * (1.f + x * (0.5f + x * (0.16666667f + x * (0.041666668f + x * (0.008333334f + x * 0.0013888889f)))));
  return (x > -0.5f) ? pl : 1.f - __expf(x);
}

struct GTile { const bf16_t* A; int lda; const bf16_t* Bt; int ldb; int K; };
DEV int stage_next(int s) { return (s == 2 * GS_STAGE) ? 0 : s + GS_STAGE; }
template <int N> DEV void vm_wait_bar() {
  if constexpr (N >= 63) asm volatile("s_waitcnt vmcnt(63) lgkmcnt(0)" ::: "memory");
  else if constexpr (N >= 38) asm volatile("s_waitcnt vmcnt(38) lgkmcnt(0)" ::: "memory");
  else if constexpr (N >= 22) asm volatile("s_waitcnt vmcnt(22) lgkmcnt(0)" ::: "memory");
  else if constexpr (N >= 14) asm volatile("s_waitcnt vmcnt(14) lgkmcnt(0)" ::: "memory");
  else if constexpr (N >= 6) asm volatile("s_waitcnt vmcnt(6) lgkmcnt(0)" ::: "memory");
  else asm volatile("s_waitcnt vmcnt(0) lgkmcnt(0)" ::: "memory");
  __builtin_amdgcn_s_barrier(); asm volatile("" ::: "memory");
}
#define GK_SRC(t_) \
  const int lr_ = lane >> 3, lc_ = lane & 7; const char* pa[2]; const char* pb[4]; \
  _Pragma("unroll") for (int i = 0; i < 2; ++i) { const int r = 8 * (wid + 8 * i) + lr_; pa[i] = (const char*)(t_).A + ((size_t)r * (t_).lda + ((lc_ ^ ((r >> 1) & 7)) << 3)) * 2; } \
  _Pragma("unroll") for (int i = 0; i < 4; ++i) { const int r = 8 * (wid + 8 * i) + lr_; pb[i] = (const char*)(t_).Bt + ((size_t)r * (t_).ldb + ((lc_ ^ ((r >> 1) & 7)) << 3)) * 2; } \
  const int dsta = GS_A + wid * 1024, dstb = GS_B + wid * 1024;
#define GK_DMA(st_, kt_) do { \
    _Pragma("unroll") for (int i = 0; i < 2; ++i) __builtin_amdgcn_global_load_lds((const unsigned*)(pa[i] + (size_t)(kt_) * 128), (lds_u32*)(smem + (st_) + dsta + i * 8192), 16, 0, 0); \
    _Pragma("unroll") for (int i = 0; i < 4; ++i) __builtin_amdgcn_global_load_lds((const unsigned*)(pb[i] + (size_t)(kt_) * 128), (lds_u32*)(smem + (st_) + dstb + i * 8192), 16, 0, 0); } while (0)
DEV void gk_issue2(const GTile& t, int s0) {
  const int tid = tid_l(), lane = tid & 63, wid = __builtin_amdgcn_readfirstlane(tid >> 6);
  GK_SRC(t)
  asm volatile("" ::: "memory");
  GK_DMA(s0, 0);
  GK_DMA(stage_next(s0), 1);
  asm volatile("" ::: "memory");
}
template <int WAIT0>
DEV void gk_main(f32x16 (&acc)[2][2], const GTile& t, int s0) {
  const int tid = tid_l(), lane = tid & 63, wid = __builtin_amdgcn_readfirstlane(tid >> 6), wm = wid & 1, wn = wid >> 1, l32 = lane & 31, hi = lane >> 5;
  GK_SRC(t)
  const int sw = (l32 >> 1) & 7;
  int xk[4], wk[4];
#pragma unroll
  for (int ks = 0; ks < 4; ++ks) { const int ko = ((2 * ks + hi) ^ sw) << 4; xk[ks] = GS_A + (64 * wm + l32) * 128 + ko; wk[ks] = GS_B + (64 * wn + l32) * 128 + ko; }
  const int nk = t.K >> 6;
#define GK_COMPUTE(st_) do { \
    _Pragma("unroll") for (int ks = 0; ks < 4; ++ks) { \
      bf16x8 xf[2], wf[2]; \
      _Pragma("unroll") for (int mb = 0; mb < 2; ++mb) xf[mb] = *(const bf16x8*)(smem + (st_) + xk[ks] + mb * 4096); \
      _Pragma("unroll") for (int nb = 0; nb < 2; ++nb) wf[nb] = *(const bf16x8*)(smem + (st_) + wk[ks] + nb * 4096); \
      _Pragma("unroll") for (int nb = 0; nb < 2; ++nb) \
        _Pragma("unroll") for (int mb = 0; mb < 2; ++mb) acc[nb][mb] = __builtin_amdgcn_mfma_f32_32x32x16_bf16(wf[nb], xf[mb], acc[nb][mb], 0, 0, 0); } } while (0)
  vm_wait_bar<WAIT0>();
  int stc = s0, std_ = stage_next(stage_next(s0));
#pragma nounroll
  for (int kt = 0; kt < nk - 2; ++kt) {
    GK_DMA(std_, kt + 2);
    GK_COMPUTE(stc);
    vm_wait_bar<6>();
    stc = stage_next(stc); std_ = stage_next(std_);
  }
  GK_COMPUTE(stc);
  vm_wait_bar<0>();
  stc = stage_next(stc);
  GK_COMPUTE(stc);
  vm_wait_bar<0>();
#undef GK_COMPUTE
}
DEV void acc_zero(f32x16 (&acc)[2][2]);
template <int WAIT_E, int WAIT_O, class TileFn, class EpiFn>
DEV void gemm_seq(int ntiles, TileFn tf, EpiFn epi) {
  __syncthreads();
  int s0 = 0;
  GTile cur = tf(0);
  gk_issue2(cur, s0);
#pragma nounroll
  for (int i = 0; i < ntiles; ++i) {
    f32x16 acc[2][2]; acc_zero(acc);
    if (i == 0) gk_main<6>(acc, cur, s0);
    else if (i & 1) gk_main<WAIT_O>(acc, cur, s0);
    else gk_main<WAIT_E>(acc, cur, s0);
    const int sn = stage_next(s0);
    if (i + 1 < ntiles) { cur = tf(i + 1); gk_issue2(cur, sn); }
    epi(i, acc, s0);
    s0 = sn;
  }
  asm volatile("s_waitcnt vmcnt(0)" ::: "memory");
}
DEV void epi_resid_f32(const f32x16 (&acc)[2][2], const float* base, float* out, int m0, int n0, int stg) {
  const int tid = tid_l(), lane = tid & 63, wid = tid >> 6, wm = wid & 1, wn = wid >> 1, l32 = lane & 31, hi = lane >> 5;
  unsigned char* wl = smem + stg + wid * 6144;
  const size_t o0 = (size_t)(m0 + 64 * wm + (lane >> 3)) * DM + n0 + 64 * wn + (lane & 7) * 4;
  f32x4 bb[2][2][4];
#pragma unroll
  for (int mb = 0; mb < 2; ++mb)
#pragma unroll
    for (int nb = 0; nb < 2; ++nb)
#pragma unroll
      for (int it = 0; it < 4; ++it) bb[mb][nb][it] = *(const f32x4*)(base + o0 + (size_t)(32 * mb + 8 * it) * DM + 32 * nb);
#pragma unroll
  for (int mb = 0; mb < 2; ++mb)
#pragma unroll
    for (int nb = 0; nb < 2; ++nb) {
#pragma unroll
      for (int rq = 0; rq < 4; ++rq) {
        f32x4 v; v[0] = acc[nb][mb][4 * rq]; v[1] = acc[nb][mb][4 * rq + 1]; v[2] = acc[nb][mb][4 * rq + 2]; v[3] = acc[nb][mb][4 * rq + 3];
        *(f32x4*)(wl + l32 * LROW + (8 * rq + 4 * hi) * 4) = v;
      }
#pragma unroll
      for (int it = 0; it < 4; ++it) {
        const f32x4 v = *(const f32x4*)(wl + (it * 8 + (lane >> 3)) * LROW + (lane & 7) * 16);
        *(f32x4*)(out + o0 + (size_t)(32 * mb + 8 * it) * DM + 32 * nb) = v + bb[mb][nb][it];
      }
    }
}
template <class F> DEV void epi_rows_bf16(const f32x16 (&acc)[2][2], int stg, F f) {
  const int tid = tid_l(), lane = tid & 63, wid = tid >> 6, wm = wid & 1, wn = wid >> 1, l32 = lane & 31, hi = lane >> 5;
  unsigned char* wl = smem + stg + wid * 6144;
#pragma unroll
  for (int mb = 0; mb < 2; ++mb) {
#pragma unroll
    for (int nb = 0; nb < 2; ++nb)
#pragma unroll
      for (int rq = 0; rq < 4; ++rq) {
        u32x2 o; o[0] = pk2(acc[nb][mb][4 * rq], acc[nb][mb][4 * rq + 1]); o[1] = pk2(acc[nb][mb][4 * rq + 2], acc[nb][mb][4 * rq + 3]);
        *(u32x2*)(wl + l32 * LROW + (32 * nb + 8 * rq + 4 * hi) * 2) = o;
      }
#pragma unroll
    for (int it = 0; it < 4; ++it) {
      const int row = it * 8 + (lane >> 3), c8 = (lane & 7) * 8;
      const u32x4 v = *(const u32x4*)(wl + row * LROW + c8 * 2);
      f(64 * wm + 32 * mb + row, 64 * wn + c8, v);
    }
  }
}
DEV void acc_zero(f32x16 (&acc)[2][2]) {
#pragma unroll
  for (int a = 0; a < 2; ++a)
#pragma unroll
    for (int b = 0; b < 2; ++b)
#pragma unroll
      for (int r = 0; r < 16; ++r) acc[a][b][r] = 0.f;
}
#define GEO const int tid = tid_l(), lane = tid & 63, wid = tid >> 6, wm = wid & 1, wn = wid >> 1, l32 = lane & 31, hi = lane >> 5; (void)wm; (void)wn; (void)l32; (void)hi; (void)lane; (void)wid;
#define FOR_ACC _Pragma("unroll") for (int nb = 0; nb < 2; ++nb) _Pragma("unroll") for (int mb = 0; mb < 2; ++mb) _Pragma("unroll") for (int rq = 0; rq < 4; ++rq)

DEV void transpose_job(const float* __restrict__ W, int K, int N, int ldw, bf16_t* Wt, int ldt) {
  float* tile = (float*)smem;
  const int tid = tid_l(); const int ntn = N >> 6, ntiles = (K >> 6) * ntn;
  for (int t = blockIdx.x; t < ntiles; t += gridDim.x) {
    const int k0 = (t / ntn) << 6, n0 = (t % ntn) << 6;
    __syncthreads();
#pragma unroll
    for (int q = 0; q < 2; ++q) {
      const int id = tid + q * 512, i = id >> 4, c4 = (id & 15) << 2;
      const f32x4 v = *(const f32x4*)(W + (size_t)(k0 + i) * ldw + n0 + c4);
      tile[i * 65 + c4 + 0] = v[0]; tile[i * 65 + c4 + 1] = v[1]; tile[i * 65 + c4 + 2] = v[2]; tile[i * 65 + c4 + 3] = v[3];
    }
    __syncthreads();
    const int n = tid >> 3, kc = (tid & 7) << 3;
    u32x4 o;
    o[0] = pk2(tile[(kc + 0) * 65 + n], tile[(kc + 1) * 65 + n]); o[1] = pk2(tile[(kc + 2) * 65 + n], tile[(kc + 3) * 65 + n]);
    o[2] = pk2(tile[(kc + 4) * 65 + n], tile[(kc + 5) * 65 + n]); o[3] = pk2(tile[(kc + 6) * 65 + n], tile[(kc + 7) * 65 + n]);
    *(u32x4*)(Wt + (size_t)(n0 + n) * ldt + k0 + kc) = o;
  }
  __syncthreads();
}
DEV void convert_job(const float* __restrict__ src, bf16_t* dst, size_t n) {
  const size_t stride = (size_t)gridDim.x * 512 * 8;
  for (size_t i = ((size_t)blockIdx.x * 512 + threadIdx.x) * 8; i < n; i += stride) {
    const f32x4 a = *(const f32x4*)(src + i), b = *(const f32x4*)(src + i + 4);
    u32x4 o; o[0] = pk2(a[0], a[1]); o[1] = pk2(a[2], a[3]); o[2] = pk2(b[0], b[1]); o[3] = pk2(b[2], b[3]);
    *(u32x4*)(dst + i) = o;
  }
}

DEV void convert_fp8_job(const float* __restrict__ src, unsigned char* dst, size_t n) {
  const size_t stride = (size_t)gridDim.x * 512 * 16;
  for (size_t i = ((size_t)blockIdx.x * 512 + threadIdx.x) * 16; i < n; i += stride) {
    u32x4 o;
#pragma unroll
    for (int q = 0; q < 4; ++q) {
      const f32x4 a = *(const f32x4*)(src + i + 4 * q);
      int d = __builtin_amdgcn_cvt_pk_fp8_f32(a[0] * 64.f, a[1] * 64.f, 0, false);
      d = __builtin_amdgcn_cvt_pk_fp8_f32(a[2] * 64.f, a[3] * 64.f, d, true);
      o[q] = (unsigned)d;
    }
    *(u32x4*)(dst + i) = o;
  }
}
DEV void panel_rmsnorm(const float* src, const float* __restrict__ gain, bf16_t* dst, int m0) {
  GEO
  f32x4 g[4];
#pragma unroll
  for (int j = 0; j < 4; ++j) g[j] = *(const f32x4*)(gain + j * 256 + lane * 4);
#pragma nounroll
  for (int i = 0; i < 16; i += 4) {
    f32x4 v[4][4];
#pragma unroll
    for (int r = 0; r < 4; ++r)
#pragma unroll
      for (int j = 0; j < 4; ++j) v[r][j] = *(const f32x4*)(src + (size_t)(m0 + wid * 16 + i + r) * DM + j * 256 + lane * 4);
#pragma unroll
    for (int r = 0; r < 4; ++r) {
      float s = 0.f;
#pragma unroll
      for (int j = 0; j < 4; ++j) s += v[r][j][0] * v[r][j][0] + v[r][j][1] * v[r][j][1] + v[r][j][2] * v[r][j][2] + v[r][j][3] * v[r][j][3];
      const float rstd = rsqrtf(wave_sum(s) * (1.f / DM) + EPS);
#pragma unroll
      for (int j = 0; j < 4; ++j) {
        u32x2 o; o[0] = pk2(v[r][j][0] * rstd * g[j][0], v[r][j][1] * rstd * g[j][1]); o[1] = pk2(v[r][j][2] * rstd * g[j][2], v[r][j][3] * rstd * g[j][3]);
        *(u32x2*)(dst + (size_t)(m0 + wid * 16 + i + r) * DM + j * 256 + lane * 4) = o;
      }
    }
  }
}

DEV void p1_panel(const Params& P, int p) {
  GEO
  const int m0 = p * 128;
  bf16_t* hn = (bf16_t*)(P.ws + WS_HN);
  bf16_t* z = (bf16_t*)(P.ws + WS_Z);
  bf16_t* vt = (bf16_t*)(P.ws + WS_VT);
  float* floc = (float*)(P.ws + WS_FLOC);
  float* ptot = (float*)(P.ws + WS_PTOT);
  float* lf = (float*)(smem + LDS_MISC);
  {
    float wfr[4][4][8]; f32x4 g[4];
#pragma unroll
    for (int j = 0; j < 4; ++j) {
      g[j] = *(const f32x4*)(P.norm_mix + j * 256 + lane * 4);
#pragma unroll
      for (int e = 0; e < 4; ++e) {
        const float* wp = P.even_w_in + (size_t)(j * 256 + lane * 4 + e) * 3080 + 3072;
        const f32x4 a = *(const f32x4*)wp, b = *(const f32x4*)(wp + 4);
        wfr[j][e][0] = a[0]; wfr[j][e][1] = a[1]; wfr[j][e][2] = a[2]; wfr[j][e][3] = a[3];
        wfr[j][e][4] = b[0]; wfr[j][e][5] = b[1]; wfr[j][e][6] = b[2]; wfr[j][e][7] = b[3];
      }
    }
#pragma nounroll
    for (int i2 = 0; i2 < 16; i2 += 2) {
      f32x4 vv[2][4];
#pragma unroll
      for (int r = 0; r < 2; ++r)
#pragma unroll
        for (int j = 0; j < 4; ++j) vv[r][j] = *(const f32x4*)(P.x + (size_t)(m0 + wid * 16 + i2 + r) * DM + j * 256 + lane * 4);
#pragma unroll
      for (int r = 0; r < 2; ++r) {
        const int i = i2 + r;
        const size_t row = (size_t)(m0 + wid * 16 + i) * DM;
        float s = 0.f;
#pragma unroll
        for (int j = 0; j < 4; ++j) s += vv[r][j][0] * vv[r][j][0] + vv[r][j][1] * vv[r][j][1] + vv[r][j][2] * vv[r][j][2] + vv[r][j][3] * vv[r][j][3];
        const float rstd = rsqrtf(wave_sum(s) * (1.f / DM) + EPS);
        float fs[8];
#pragma unroll
        for (int h = 0; h < 8; ++h) fs[h] = 0.f;
#pragma unroll
        for (int j = 0; j < 4; ++j) {
          float hv[4];
#pragma unroll
          for (int e = 0; e < 4; ++e) {
            hv[e] = vv[r][j][e] * rstd * g[j][e];
#pragma unroll
            for (int h = 0; h < 8; ++h) fs[h] += hv[e] * wfr[j][e][h];
          }
          u32x2 o; o[0] = pk2(hv[0], hv[1]); o[1] = pk2(hv[2], hv[3]);
          *(u32x2*)(hn + row + j * 256 + lane * 4) = o;
        }
#pragma unroll
        for (int h = 0; h < 8; ++h) fs[h] = wave_sum(fs[h]);
        if (lane < 8) {
          float f = fs[0];
#pragma unroll
          for (int h = 1; h < 8; ++h) f = (lane == h) ? fs[h] : f;
          const float xx = f + P.even_b_forget[lane];
          lf[(wid * 16 + i) * 8 + lane] = fminf(xx, 0.f) - log1pf(__expf(-fabsf(xx)));
        }
      }
    }
  }
  __syncthreads();
  if (tid < 8) {
    const int b = m0 / SEQ, s0 = m0 % SEQ;
    float cum = 0.f; float* fo = floc + (size_t)(b * 8 + tid) * SEQ + s0;
    for (int t = 0; t < 128; ++t) { cum += lf[t * 8 + tid]; fo[t] = cum; }
    ptot[p * 8 + tid] = cum;
  }
  const bf16_t* wt = (const bf16_t*)(P.ws + W_IN0);
  gemm_seq<14, 14>(12, [&](int nt) { return GTile{hn + (size_t)m0 * DM, DM, wt + (size_t)nt * 256 * DM, DM, DM}; }, [&](int nt, f32x16 (&acc)[2][2], int stg) {
    const int n0 = nt * 256;
    if (nt < 10) {
      if (nt >= 6) {
        const bool isq = nt < 8;
        const float* gn = isq ? P.even_q_gain : P.even_k_gain;
        const float extra = isq ? 0.125f * LOG2E : 1.f;
#pragma unroll
        for (int mb = 0; mb < 2; ++mb) {
          float s = 0.f;
#pragma unroll
          for (int nb = 0; nb < 2; ++nb)
#pragma unroll
            for (int r = 0; r < 16; ++r) s += acc[nb][mb][r] * acc[nb][mb][r];
          s += __shfl_xor(s, 32);
          const float rstd = rsqrtf(s * (1.f / 64.f) + EPS) * extra;
#pragma unroll
          for (int nb = 0; nb < 2; ++nb)
#pragma unroll
            for (int rq = 0; rq < 4; ++rq) {
              const f32x4 gg = *(const f32x4*)(gn + 32 * nb + 8 * rq + 4 * hi);
#pragma unroll
              for (int e = 0; e < 4; ++e) acc[nb][mb][4 * rq + e] *= rstd * gg[e];
            }
        }
      }
      epi_rows_bf16(acc, stg, [&](int tr, int cr, u32x4 v) { *(u32x4*)(z + (size_t)(m0 + tr) * 3072 + n0 + cr) = v; });
    } else {
      FOR_ACC {
        const int tok = m0 + 64 * wm + 32 * mb + l32, col = n0 + 64 * wn + 32 * nb + 8 * rq + 4 * hi - 2560;
        const int b = tok / SEQ, s = tok % SEQ;
#pragma unroll
        for (int e = 0; e < 4; ++e) vt[(size_t)(b * 512 + col + e) * SEQ + s] = f2bf(acc[nb][mb][4 * rq + e]);
      }
    }
  });
}
DEV void fold_unit(const Params& P, int u) {
  GEO
  const int l = u >> 6, jt = (u >> 3) & 7, hh = u & 7;
  const bf16_t* A = (const bf16_t*)(P.ws + W_QB) + (size_t)l * 1024 * 2048 + (size_t)(jt * 128) * 2048 + hh * 256;
  const bf16_t* Bt = (const bf16_t*)(P.ws + W_SK) + (size_t)l * 65536;
  bf16_t* wpt = (bf16_t*)(P.ws + W_PT);
  gemm_seq<6, 6>(1, [&](int) { return GTile{A, 2048, Bt, 256, 256}; }, [&](int, f32x16 (&acc)[2][2], int) {
    FOR_ACC {
      const int j = jt * 128 + 64 * wm + 32 * mb + l32, n = 64 * wn + 32 * nb + 8 * rq + 4 * hi;
#pragma unroll
      for (int e = 0; e < 4; ++e) wpt[((size_t)l * 2048 + hh * 256 + n + e) * 1024 + j] = f2bf(acc[nb][mb][4 * rq + e]);
    }
  });
}

constexpr int VROW = 272;
constexpr int AT_K = 0, AT_V = 128 * LROW, AT_BIAS = AT_V + 64 * VROW, AT_STG = AT_BIAS + 512;
constexpr int AT_GRP = 2 * AT_STG;
constexpr int AT_SUF = 2 * AT_GRP;
constexpr int AT_OFF = AT_SUF + 1280;
static_assert(AT_OFF + 8192 <= LDS_BYTES - 64, "attention LDS map");
DEV int crow(int r, int hi) { return 8 * (r >> 2) + 4 * hi + (r & 3); }

constexpr float SKIP_THR = 80.f;
DEV void attn_unit(const Params& P, int b, int qb, int h) {
  const int tid = tid_l(), lane = tid & 63, wid = tid >> 6, l32 = lane & 31, hi = lane >> 5;
  const int g = wid >> 2, wq = wid & 3, gt = tid & 255;
  const bf16_t* z = (const bf16_t*)(P.ws + WS_Z);
  const bf16_t* vt = (const bf16_t*)(P.ws + WS_VT);
  bf16_t* ycat = (bf16_t*)(P.ws + WS_HN);
  const float* fl = (const float*)(P.ws + WS_FLOC) + (size_t)(b * 8 + h) * SEQ;
  const float* ptot = (const float*)(P.ws + WS_PTOT);
  float* suf = (float*)(smem + AT_SUF) + g * 128;
  __syncthreads();
  {
    const float* offt = (const float*)(smem + AT_OFF) + (b * 8 + h) * 128;
    if (gt < 128) suf[gt] = (gt < qb) ? (offt[qb] - offt[gt]) : 0.f;
  }
  __syncthreads();
  const int tokq = b * SEQ + qb * 128 + wq * 32 + l32;
  bf16x8 qf[4];
#pragma unroll
  for (int d0 = 0; d0 < 4; ++d0) qf[d0] = *(const bf16x8*)(z + (size_t)tokq * 3072 + 1536 + h * 64 + d0 * 16 + hi * 8);
  const float fend = fl[qb * 128 + 127];
  const int NT = 2 * qb + 2;
  int t_start;
  {
    const float D2 = (fl[qb * 128] - fend) * LOG2E;
    int* tsl = (int*)(smem + AT_SUF + 1024);
    bool skip = false;
    if (gt < NT) { const int j = 64 * gt + 63; skip = ((fend - fl[j] + suf[j >> 7]) * LOG2E + D2 < -SKIP_THR); }
    const unsigned long long bal = __ballot(skip);
    if (lane == 0) tsl[wid] = __popcll(bal);
    __syncthreads();
    const int c0 = tsl[0] + tsl[1] + tsl[2] + tsl[3], c1 = tsl[4] + tsl[5] + tsl[6] + tsl[7];
    t_start = min(min(c0, c1), 2 * qb);
  }
  const int t_start64 = t_start;
  const int NT2 = qb + 1;
  const int ts2 = t_start64 >> 1;
  const int kc = gt & 7, kr = gt >> 3, vc = gt & 15, vr = gt >> 4;
  const bf16_t* kg = z + (size_t)(b * SEQ + kr) * 3072 + 2048 + h * 64 + kc * 8;
  const bf16_t* vg = vt + (size_t)((b * 8 + h) * 64 + vr) * SEQ + vc * 8;
  const int gbase = g * AT_GRP;
  const int sk_ = kr * LROW + kc * 16, sv_ = vr * VROW + vc * 16;
  u32x4 rk[4], rv[4]; float rbias = 0.f;
#define AT_LOAD(t) do { \
    _Pragma("unroll") for (int i_ = 0; i_ < 4; ++i_) { rk[i_] = *(const u32x4*)(kg + (size_t)((t) * 128 + 32 * i_) * 3072); rv[i_] = *(const u32x4*)(vg + (size_t)(16 * i_) * SEQ + (t) * 128); } \
    if (gt < 128) { const int j_ = (t) * 128 + gt; rbias = (fend - fl[j_] + suf[j_ >> 7]) * LOG2E; } } while (0)
#define AT_STORE(st) do { \
    _Pragma("unroll") for (int i_ = 0; i_ < 4; ++i_) { *(u32x4*)(smem + (st) + AT_K + sk_ + 32 * i_ * LROW) = rk[i_]; *(u32x4*)(smem + (st) + AT_V + sv_ + 16 * i_ * VROW) = rv[i_]; } \
    if (gt < 128) *(float*)(smem + (st) + AT_BIAS + gt * 4) = rbias; } while (0)
  const int niter = (NT2 - ts2 + 1) >> 1;
  if (ts2 + g < NT2) { AT_LOAD(ts2 + g); AT_STORE(gbase); }
  __syncthreads();
  float m = -INFINITY, l = 0.f;
  f32x16 o[2];
#pragma unroll
  for (int r = 0; r < 16; ++r) { o[0][r] = 0.f; o[1][r] = 0.f; }
#pragma nounroll
  for (int it = 0; it < niter; ++it) {
    const int t2 = ts2 + 2 * it + g;
    const int st = gbase + (it & 1) * AT_STG;
    const bool more = t2 + 2 < NT2;
    if (more) AT_LOAD(t2 + 2);
#pragma nounroll
   for (int sub = 0; sub < 2; ++sub) {
    const int t = 2 * t2 + sub;
    const bool active = (t2 < NT2) && (t >= t_start64) && !(t == 2 * qb + 1 && wq < 2);
    if (active) {
      f32x16 s0, s1;
#pragma unroll
      for (int rq = 0; rq < 4; ++rq) {
        const f32x4 b0 = *(const f32x4*)(smem + st + AT_BIAS + (64 * sub + 8 * rq + 4 * hi) * 4);
        const f32x4 b1 = *(const f32x4*)(smem + st + AT_BIAS + (64 * sub + 32 + 8 * rq + 4 * hi) * 4);
#pragma unroll
        for (int e = 0; e < 4; ++e) { s0[4 * rq + e] = b0[e]; s1[4 * rq + e] = b1[e]; }
      }
#pragma unroll
      for (int d0 = 0; d0 < 4; ++d0) {
        const bf16x8 k0 = *(const bf16x8*)(smem + st + AT_K + (64 * sub + l32) * LROW + d0 * 32 + hi * 16);
        const bf16x8 k1 = *(const bf16x8*)(smem + st + AT_K + (64 * sub + 32 + l32) * LROW + d0 * 32 + hi * 16);
        s0 = __builtin_amdgcn_mfma_f32_32x32x16_bf16(k0, qf[d0], s0, 0, 0, 0);
        s1 = __builtin_amdgcn_mfma_f32_32x32x16_bf16(k1, qf[d0], s1, 0, 0, 0);
      }
      if (t >= 2 * qb) {
        const int kb = 64 * (t - 2 * qb), qrel = 32 * wq + l32;
#pragma unroll
        for (int r = 0; r < 16; ++r) {
          const int kv = kb + crow(r, hi);
          if (kv > qrel) s0[r] = -INFINITY;
          if (kv + 32 > qrel) s1[r] = -INFINITY;
        }
      }
      float mx = s0[0];
#pragma unroll
      for (int r = 1; r < 16; ++r) mx = fmaxf(mx, s0[r]);
#pragma unroll
      for (int r = 0; r < 16; ++r) mx = fmaxf(mx, s1[r]);
      mx = fmaxf(mx, __shfl_xor(mx, 32));
      const float mn = fmaxf(m, mx);
      const float alpha = __builtin_amdgcn_exp2f(m - mn);
      m = mn;
      float ls = 0.f;
#pragma unroll
      for (int r = 0; r < 16; ++r) { s0[r] = __builtin_amdgcn_exp2f(s0[r] - mn); s1[r] = __builtin_amdgcn_exp2f(s1[r] - mn); ls += s0[r] + s1[r]; }
      l = l * alpha + ls;
      if (__any(alpha != 1.f)) {
#pragma unroll
        for (int r = 0; r < 16; ++r) { o[0][r] *= alpha; o[1][r] *= alpha; }
      }
      bf16x8 pf[2][2];
#pragma unroll
      for (int ks = 0; ks < 2; ++ks) {
        u32x4 a, c;
        a[0] = pk2(s0[8 * ks + 0], s0[8 * ks + 1]); a[1] = pk2(s0[8 * ks + 2], s0[8 * ks + 3]); a[2] = pk2(s0[8 * ks + 4], s0[8 * ks + 5]); a[3] = pk2(s0[8 * ks + 6], s0[8 * ks + 7]);
        c[0] = pk2(s1[8 * ks + 0], s1[8 * ks + 1]); c[1] = pk2(s1[8 * ks + 2], s1[8 * ks + 3]); c[2] = pk2(s1[8 * ks + 4], s1[8 * ks + 5]); c[3] = pk2(s1[8 * ks + 6], s1[8 * ks + 7]);
        pf[0][ks] = __builtin_bit_cast(bf16x8, a); pf[1][ks] = __builtin_bit_cast(bf16x8, c);
      }
#pragma unroll
      for (int pbk = 0; pbk < 2; ++pbk)
#pragma unroll
        for (int ks = 0; ks < 2; ++ks)
#pragma unroll
          for (int db = 0; db < 2; ++db) {
            const int off = st + AT_V + (32 * db + l32) * VROW + (64 * sub + 32 * pbk + 16 * ks + 4 * hi) * 2;
            const u32x2 lo = *(const u32x2*)(smem + off), hh = *(const u32x2*)(smem + off + 16);
            u32x4 vv; vv[0] = lo[0]; vv[1] = lo[1]; vv[2] = hh[0]; vv[3] = hh[1];
            o[db] = __builtin_amdgcn_mfma_f32_32x32x16_bf16(__builtin_bit_cast(bf16x8, vv), pf[pbk][ks], o[db], 0, 0, 0);
          }
    }
   }
    if (more) AT_STORE(gbase + ((it + 1) & 1) * AT_STG);
    __syncthreads();
  }
#undef AT_LOAD
#undef AT_STORE
  float* mg = (float*)(smem + AT_GRP) + (wq * 64 + lane) * 34;
  if (g == 1) {
#pragma unroll
    for (int r = 0; r < 16; ++r) { mg[r] = o[0][r]; mg[16 + r] = o[1][r]; }
    mg[32] = m; mg[33] = l;
  }
  __syncthreads();
  if (g == 0) {
    const float m1 = mg[32], l1 = mg[33];
    const float ms = fmaxf(m, m1);
    const float f0 = __builtin_amdgcn_exp2f(m - ms), f1 = __builtin_amdgcn_exp2f(m1 - ms);
    l = l * f0 + l1 * f1;
#pragma unroll
    for (int r = 0; r < 16; ++r) { o[0][r] = o[0][r] * f0 + mg[r] * f1; o[1][r] = o[1][r] * f0 + mg[16 + r] * f1; }
    l += __shfl_xor(l, 32);
    const float inv = 1.f / l;
#pragma unroll
    for (int db = 0; db < 2; ++db)
#pragma unroll
      for (int rq = 0; rq < 4; ++rq) {
        u32x2 ov; ov[0] = pk2(o[db][4 * rq] * inv, o[db][4 * rq + 1] * inv); ov[1] = pk2(o[db][4 * rq + 2] * inv, o[db][4 * rq + 3] * inv);
        *(u32x2*)(ycat + (size_t)tokq * DM + 512 + h * 64 + 32 * db + 8 * rq + 4 * hi) = ov;
      }
  }
}
DEV void conv_mixer(const Params& P, int p) {
  const int tid = tid_l(), c = 2 * (tid & 255), t0 = p * 128 + 64 * (tid >> 8);
  const bf16_t* z = (const bf16_t*)(P.ws + WS_Z);
  bf16_t* ycat = (bf16_t*)(P.ws + WS_HN);
  const float w0a = P.even_conv_w[c], w0b = P.even_conv_w[c + 1], w1a = P.even_conv_w[512 + c], w1b = P.even_conv_w[513 + c], w2a = P.even_conv_w[1024 + c], w2b = P.even_conv_w[1025 + c];
  float g2a = 0.f, g2b = 0.f, g1a = 0.f, g1b = 0.f;
  if (t0 % SEQ != 0) {
    const bf16_t* r2 = z + (size_t)(t0 - 2) * 3072, *r1 = z + (size_t)(t0 - 1) * 3072;
    const unsigned c2 = *(const unsigned*)(r2 + 512 + c), x2 = *(const unsigned*)(r2 + 1024 + c), c1 = *(const unsigned*)(r1 + 512 + c), x1 = *(const unsigned*)(r1 + 1024 + c);
    g2a = bflo(c2) * bflo(x2); g2b = bfhi(c2) * bfhi(x2); g1a = bflo(c1) * bflo(x1); g1b = bfhi(c1) * bfhi(x1);
  }
#pragma nounroll
  for (int tb = 0; tb < 64; tb += 32) {
    unsigned gb[32], gc[32], xa[32];
#pragma unroll
    for (int i = 0; i < 32; ++i) { const bf16_t* r = z + (size_t)(t0 + tb + i) * 3072 + c; gb[i] = *(const unsigned*)r; gc[i] = *(const unsigned*)(r + 512); xa[i] = *(const unsigned*)(r + 1024); }
#pragma unroll
    for (int i = 0; i < 32; ++i) {
      const float g0a = bflo(gc[i]) * bflo(xa[i]), g0b = bfhi(gc[i]) * bfhi(xa[i]);
      const float ya = bflo(gb[i]) * (w0a * g2a + w1a * g1a + w2a * g0a), yb = bfhi(gb[i]) * (w0b * g2b + w1b * g1b + w2b * g0b);
      *(unsigned*)(ycat + (size_t)(t0 + tb + i) * DM + c) = pk2(ya, yb);
      g2a = g1a; g1a = g0a; g2b = g1b; g1b = g0b;
    }
  }
}

DEV unsigned fkey(float x) { const unsigned u = __float_as_uint(x); return (u & 0x80000000u) ? ~u : (u | 0x80000000u); }
DEV float keyf(unsigned k) { const unsigned u = (k & 0x80000000u) ? (k & 0x7fffffffu) : ~k; return __uint_as_float(u); }
DEV void cswap(unsigned& a, unsigned& b) { const unsigned hi_ = max(a, b), lo_ = min(a, b); a = hi_; b = lo_; }
DEV void bitonic_merge16_desc(unsigned (&v)[16]) {
#pragma unroll
  for (int j = 8; j >= 1; j >>= 1)
#pragma unroll
    for (int i = 0; i < 16; ++i) { const int l = i ^ j; if (l > i) cswap(v[i], v[l]); }
}
DEV void bitonic_sort16_desc(unsigned (&v)[16]) {
#pragma unroll
  for (int k = 2; k <= 16; k <<= 1)
#pragma unroll
    for (int j = k >> 1; j >= 1; j >>= 1)
#pragma unroll
      for (int i = 0; i < 16; ++i) { const int l = i ^ j; if (l > i) { if ((i & k) == 0) cswap(v[i], v[l]); else cswap(v[l], v[i]); } }
}
DEV void merge_top16(unsigned (&R)[16], const unsigned (&G)[16]) {
#pragma unroll
  for (int i = 0; i < 16; ++i) R[i] = max(R[i], G[15 - i]);
  bitonic_merge16_desc(R);
}
DEV void stage1(unsigned (&L)[16], const float* sp) {
  float sv[128];
#pragma unroll
  for (int i = 0; i < 128; ++i) sv[i] = sp[(size_t)i * 128];
#pragma unroll
  for (int i = 0; i < 128; i += 16) {
    unsigned g[16];
#pragma unroll
    for (int e = 0; e < 16; ++e) g[e] = (fkey(sv[i + e]) & ~127u) | (unsigned)(127 - (i + e));
    bitonic_sort16_desc(g);
    if (i == 0) {
#pragma unroll
      for (int e = 0; e < 16; ++e) L[e] = g[e];
    } else merge_top16(L, g);
  }
}
DEV void topk_group(int hg, const float* scoresT, int* idxo, float* go) {
  const int tid = tid_l(), token = tid & 127, hl = tid >> 7;
  unsigned LA[16], LB[16], LC[16];
  stage1(LA, scoresT + (size_t)(hl * 256) * 128 + token);
  stage1(LB, scoresT + (size_t)(hl * 256 + 128) * 128 + token);
  unsigned* la = (unsigned*)smem; unsigned* lb = la + 16 * 512;
  float bv[16];
#pragma unroll
  for (int j = 0; j < 16; ++j) { bv[j] = keyf(LB[j] & ~127u); la[j * 512 + tid] = LA[j]; lb[j * 512 + tid] = LB[j]; }
  {
    constexpr int CI[64] = {0,0,0,0,0,0,0,0,0,0,0,0,0,0,0,0, 1,1,1,1,1,1,1,1, 2,2,2,2,2, 3,3,3,3, 4,4,4, 5,5, 6,6, 7,7, 8,9,10,11,12,13,14,15, 0,0,0,0,0,0,0,0,0,0,0,0,0,0};
    constexpr int CJ[64] = {0,1,2,3,4,5,6,7,8,9,10,11,12,13,14,15, 0,1,2,3,4,5,6,7, 0,1,2,3,4, 0,1,2,3, 0,1,2, 0,1, 0,1, 0,1, 0,0,0,0,0,0,0,0, 0,0,0,0,0,0,0,0,0,0,0,0,0,0};
    float av[16];
#pragma unroll
    for (int i = 0; i < 16; ++i) av[i] = keyf(LA[i] & ~127u);
#pragma unroll
    for (int gq = 0; gq < 4; ++gq) {
      unsigned g[16];
#pragma unroll
      for (int e = 0; e < 16; ++e) {
        const int ci = CI[gq * 16 + e], cj = CJ[gq * 16 + e];
        g[e] = (gq * 16 + e < 50) ? ((fkey(av[ci] + bv[cj]) & ~255u) | (unsigned)(255 - (ci * 16 + cj))) : 0u;
      }
      bitonic_sort16_desc(g);
      if (gq == 0) {
#pragma unroll
        for (int e = 0; e < 16; ++e) LC[e] = g[e];
      } else merge_top16(LC, g);
    }
  }
  const float smax = keyf(LC[0] & ~255u);
  float ev[16], sum = 0.f;
#pragma unroll
  for (int k = 0; k < 16; ++k) { ev[k] = __expf(keyf(LC[k] & ~255u) - smax); sum += ev[k]; }
  const float inv = 1.f / sum;
  const int head = hg * 4 + hl;
#pragma unroll
  for (int k = 0; k < 16; ++k) {
    const int c = 255 - (int)(LC[k] & 255u), i = c >> 4, j = c & 15;
    const int i1 = 127 - (int)(la[i * 512 + tid] & 127u), i2 = 127 - (int)(lb[j * 512 + tid] & 127u);
    idxo[token * 128 + head * 16 + k] = i1 * 128 + i2;
    go[token * 128 + head * 16 + k] = ev[k] * inv;
  }
}
DEV float sw32sum(float a, float b) { auto r = __builtin_amdgcn_permlane32_swap(__float_as_uint(a), __float_as_uint(b), false, false); return __uint_as_float(r[0]) + __uint_as_float(r[1]); }
DEV float sw16sum(float a, float b) { auto r = __builtin_amdgcn_permlane16_swap(__float_as_uint(a), __float_as_uint(b), false, false); return __uint_as_float(r[0]) + __uint_as_float(r[1]); }
template <int N> DEV float row_ror_add(float v) { return v + __uint_as_float((unsigned)__builtin_amdgcn_update_dpp(0, (int)__float_as_uint(v), 0x120 + N, 0xf, 0xf, false)); }
DEV float row_allsum(float v) { v = row_ror_add<8>(v); v = row_ror_add<4>(v); v = row_ror_add<2>(v); v = row_ror_add<1>(v); return v; }
DEV f32x2_t fp8x2(unsigned d, bool hiw) { return hiw ? __builtin_amdgcn_cvt_pk_f32_fp8((int)d, true) : __builtin_amdgcn_cvt_pk_f32_fp8((int)d, false); }
constexpr float TAB_SCALE = 64.f, TAB_INV = 1.f / 64.f;
DEV void sort_lists(int lane, int& myi0, int& myi1, float& myg0, float& myg1) {
#pragma unroll
    for (int k = 2; k <= 128; k <<= 1) {
#pragma unroll
      for (int j = k >> 1; j >= 1; j >>= 1) {
        if (j == 64) {
          const bool sw_ = myi1 < myi0;
          const int ti = sw_ ? myi1 : myi0, tj = sw_ ? myi0 : myi1; const float tg = sw_ ? myg1 : myg0, th = sw_ ? myg0 : myg1;
          myi0 = ti; myi1 = tj; myg0 = tg; myg1 = th;
        } else {
          const bool lower = (lane & j) == 0;
          {
            const bool up = (k == 128) ? true : ((k == 64) ? true : ((lane & k) == 0));
            const int oi = __shfl_xor(myi0, j); const float og = __shfl_xor(myg0, j);
            const bool take = (lower == up) ? (oi < myi0) : (oi > myi0);
            myi0 = take ? oi : myi0; myg0 = take ? og : myg0;
          }
          {
            const bool up = (k == 128) ? true : ((k == 64) ? false : ((lane & k) == 0));
            const int oi = __shfl_xor(myi1, j); const float og = __shfl_xor(myg1, j);
            const bool take = (lower == up) ? (oi < myi1) : (oi > myi1);
            myi1 = take ? oi : myi1; myg1 = take ? og : myg1;
          }
        }
      }
    }
}
DEV void peer_gather(const Params& P, int l, int m0, const int* idxs, const float* gs) {
  const int tid = tid_l(), lane = tid & 63, wid = tid >> 6;
  const unsigned char* U = P.ws + WS_TAB + (size_t)l * 32 * MB;
  const unsigned char* V = U + 16 * MB;
  bf16_t* hn = (bf16_t*)(P.ws + WS_HN);
  const float* gp = P.norm_ple + l * DM;
  const int row = lane >> 4, rmap = ((row & 1) << 1) | (row >> 1);
  u32x4 nxa = *(const u32x4*)(hn + (size_t)(m0 + wid * 16) * DM + lane * 16), nxb = *(const u32x4*)(hn + (size_t)(m0 + wid * 16) * DM + lane * 16 + 8);
  int ni0 = idxs[(wid * 16) * 128 + lane], ni1 = idxs[(wid * 16) * 128 + 64 + lane];
  float ng0 = gs[(wid * 16) * 128 + lane], ng1 = gs[(wid * 16) * 128 + 64 + lane];
  sort_lists(lane, ni0, ni1, ng0, ng1);
#pragma nounroll
  for (int i = 0; i < 16; ++i) {
    const int tt = wid * 16 + i; const size_t tok = (size_t)(m0 + tt);
    __syncthreads();
    const u32x4 xa = nxa, xb = nxb;
    f32x2_t xp[8];
#pragma unroll
    for (int q = 0; q < 4; ++q) { xp[q] = (f32x2_t){bflo(xa[q]), bfhi(xa[q])}; xp[4 + q] = (f32x2_t){bflo(xb[q]), bfhi(xb[q])}; }
    const int myi0 = ni0, myi1 = ni1;
    const float myg0 = ng0, myg1 = ng1;
    f32x2_t acc[8];
#pragma unroll
    for (int q = 0; q < 8; ++q) acc[q] = (f32x2_t){0.f, 0.f};
    float wr0 = 0.f, wr1 = 0.f;
    u32x4 b0[8], b1[8];
#define PG_ISSUE(BUF, TAB, e0_) do { const int isrc_ = ((e0_) < 64) ? myi0 : myi1; \
      _Pragma("unroll") for (int e = 0; e < 8; ++e) { const int idx_ = __builtin_amdgcn_readlane(isrc_, ((e0_) + e) & 63); \
        BUF[e] = *(const u32x4*)((TAB) + (size_t)idx_ * 1024 + lane * 16); } } while (0)
#define PG_U8(BUF, o_, e0_) do { float d_[8]; \
      _Pragma("unroll") for (int e = 0; e < 8; ++e) { f32x2_t s_ = {0.f, 0.f}; \
        _Pragma("unroll") for (int q = 0; q < 4; ++q) { s_ = __builtin_elementwise_fma(xp[2 * q], fp8x2(BUF[(o_) + e][q], false), s_); s_ = __builtin_elementwise_fma(xp[2 * q + 1], fp8x2(BUF[(o_) + e][q], true), s_); } \
        d_[e] = s_[0] + s_[1]; } \
      float s0_ = sw16sum(sw32sum(d_[0], d_[1]), sw32sum(d_[2], d_[3])); \
      float s1_ = sw16sum(sw32sum(d_[4], d_[5]), sw32sum(d_[6], d_[7])); \
      s0_ = row_allsum(s0_) * TAB_INV; s1_ = row_allsum(s1_) * TAB_INV; \
      const float gsrc_ = ((e0_) < 64) ? myg0 : myg1; \
      const float w0_ = __shfl(gsrc_, ((e0_) + (o_) + rmap) & 63) * gelu_tanh(s0_), w1_ = __shfl(gsrc_, ((e0_) + (o_) + 4 + rmap) & 63) * gelu_tanh(s1_); \
      _Pragma("unroll") for (int e = 0; e < 8; ++e) { const int rw_ = (((e & 1) << 1) | ((e >> 1) & 1)) * 16; \
        const float we_ = __uint_as_float(__builtin_amdgcn_readlane(__float_as_uint((e < 4) ? w0_ : w1_), rw_)); \
        if ((e0_) < 64) wr0 = (lane == (((e0_) + (o_) + e) & 63)) ? we_ : wr0; else wr1 = (lane == (((e0_) + (o_) + e) & 63)) ? we_ : wr1; } } while (0)
#define PG_V16(BUF, e0_) do { const float wsrc_ = ((e0_) < 64) ? wr0 : wr1; \
      _Pragma("unroll") for (int e = 0; e < 8; ++e) { \
        const float we_ = __uint_as_float(__builtin_amdgcn_readlane(__float_as_uint(wsrc_), ((e0_) + e) & 63)); const f32x2_t w2_ = {we_, we_}; \
        _Pragma("unroll") for (int q = 0; q < 4; ++q) { acc[2 * q] = __builtin_elementwise_fma(w2_, fp8x2(BUF[e][q], false), acc[2 * q]); acc[2 * q + 1] = __builtin_elementwise_fma(w2_, fp8x2(BUF[e][q], true), acc[2 * q + 1]); } } } while (0)
    PG_ISSUE(b0, U, 0);
#pragma nounroll
    for (int e0 = 0; e0 < 128; e0 += 16) {
      PG_ISSUE(b1, U, e0 + 8);
      PG_U8(b0, 0, e0);
      if (e0 + 16 < 128) PG_ISSUE(b0, U, e0 + 16); else PG_ISSUE(b0, V, 0);
      PG_U8(b1, 0, e0 + 8);
    }
    float* hrow = P.out + tok * DM + lane * 16;
    f32x4 hv[4];
#pragma unroll
    for (int q = 0; q < 4; ++q) hv[q] = *(const f32x4*)(hrow + 4 * q);
    if (i + 1 < 16) {
      const int tn = tt + 1;
      nxa = *(const u32x4*)(hn + (size_t)(m0 + tn) * DM + lane * 16); nxb = *(const u32x4*)(hn + (size_t)(m0 + tn) * DM + lane * 16 + 8);
      ni0 = idxs[tn * 128 + lane]; ni1 = idxs[tn * 128 + 64 + lane]; ng0 = gs[tn * 128 + lane]; ng1 = gs[tn * 128 + 64 + lane];
    }
#pragma nounroll
    for (int e0 = 0; e0 < 128; e0 += 16) {
      PG_ISSUE(b1, V, e0 + 8);
      if (e0 == 64 && i + 1 < 16) sort_lists(lane, ni0, ni1, ng0, ng1);
      PG_V16(b0, e0);
      if (e0 + 16 < 128) PG_ISSUE(b0, V, e0 + 16);
      PG_V16(b1, e0 + 8);
    }
#undef PG_ISSUE
#undef PG_U8
#undef PG_V16
    float ss = 0.f;
#pragma unroll
    for (int q = 0; q < 4; ++q) {
      hv[q][0] += acc[2 * q][0] * TAB_INV; hv[q][1] += acc[2 * q][1] * TAB_INV; hv[q][2] += acc[2 * q + 1][0] * TAB_INV; hv[q][3] += acc[2 * q + 1][1] * TAB_INV;
      ss += hv[q][0] * hv[q][0] + hv[q][1] * hv[q][1] + hv[q][2] * hv[q][2] + hv[q][3] * hv[q][3];
      *(f32x4*)(hrow + 4 * q) = hv[q];
    }
    const float rstd = rsqrtf(wave_sum(ss) * (1.f / DM) + EPS);
    u32x4 oa, ob;
#pragma unroll
    for (int q = 0; q < 4; ++q) {
      const f32x4 g = *(const f32x4*)(gp + lane * 16 + 4 * q);
      const unsigned p0 = pk2(hv[q][0] * rstd * g[0], hv[q][1] * rstd * g[1]), p1 = pk2(hv[q][2] * rstd * g[2], hv[q][3] * rstd * g[3]);
      if (q < 2) { oa[2 * q] = p0; oa[2 * q + 1] = p1; } else { ob[2 * (q - 2)] = p0; ob[2 * (q - 2) + 1] = p1; }
    }
    *(u32x4*)(hn + tok * DM + lane * 16) = oa; *(u32x4*)(hn + tok * DM + lane * 16 + 8) = ob;
  }
}
DEV void resid_gemm(const Params& P, int m0, const bf16_t* A, const bf16_t* Wt, const float* base) {
  gemm_seq<22, 22>(4, [&](int nt) { return GTile{A + (size_t)m0 * DM, DM, Wt + (size_t)nt * 256 * DM, DM, DM}; },
                   [&](int nt, f32x16 (&acc)[2][2], int stg) { epi_resid_f32(acc, base, P.out, m0, nt * 256, stg); });
}
DEV void chain_peer_ple(const Params& P, int l, int p) {
  GEO
  const int m0 = p * 128;
  bf16_t* hn = (bf16_t*)(P.ws + WS_HN);
  unsigned char* slice = P.ws + WS_Z + (size_t)p * SLICE;
  float* scoresT = (float*)slice; int* idxs = (int*)(slice + 512 * 1024); float* gs = (float*)(slice + 576 * 1024);
  __syncthreads();
  panel_rmsnorm(P.out, P.norm_ffn + l * DM, hn, m0);
  const bf16_t* wpt = (const bf16_t*)(P.ws + W_PT) + (size_t)l * 2048 * 1024;
#pragma nounroll
  for (int hg = 0; hg < 2; ++hg) {
    gemm_seq<63, 63>(4, [&](int nt) { return GTile{hn + (size_t)m0 * DM, DM, wpt + (size_t)((hg * 4 + nt) * 256) * DM, DM, DM}; }, [&](int nt, f32x16 (&acc)[2][2], int) {
      FOR_ACC {
        const int tr = 64 * wm + 32 * mb + l32, col = nt * 256 + 64 * wn + 32 * nb + 8 * rq + 4 * hi;
#pragma unroll
        for (int e = 0; e < 4; ++e) scoresT[(size_t)(col + e) * 128 + tr] = acc[nb][mb][4 * rq + e];
      }
    });
    __syncthreads();
    if (l == 0 && hg == 0) STAMP(16);
    topk_group(hg, scoresT, idxs, gs);
    __syncthreads();
    if (l == 0 && hg == 0) STAMP(17);
  }
  if (l == 0) STAMP(12);
  peer_gather(P, l, m0, idxs, gs);
  __syncthreads();
  if (l == 0) STAMP(13);
  const bf16_t* wg = (const bf16_t*)(P.ws + W_GATE) + (size_t)l * 1024 * 1024;
  const bf16_t* wu = (const bf16_t*)(P.ws + W_UP) + (size_t)l * 1024 * 256;
  const bf16_t* pb = (const bf16_t*)(P.ws + WS_PB) + ((size_t)l * T_TOK + m0) * 256;
  {
    unsigned sg[2][2][8];
    gemm_seq<22, 6>(8, [&](int i) { const int nt = i >> 1;
        return (i & 1) ? GTile{pb, 256, wu + (size_t)nt * 256 * 256, 256, 256} : GTile{hn + (size_t)m0 * DM, DM, wg + (size_t)nt * 256 * DM, DM, DM}; },
      [&](int i, f32x16 (&acc)[2][2], int stg) {
        if (!(i & 1)) {
#pragma unroll
          for (int nb = 0; nb < 2; ++nb)
#pragma unroll
            for (int mb = 0; mb < 2; ++mb)
#pragma unroll
              for (int q = 0; q < 8; ++q) sg[nb][mb][q] = pk2(sigmoidf_(acc[nb][mb][2 * q]), sigmoidf_(acc[nb][mb][2 * q + 1]));
        } else {
#pragma unroll
          for (int nb = 0; nb < 2; ++nb)
#pragma unroll
            for (int mb = 0; mb < 2; ++mb)
#pragma unroll
              for (int q = 0; q < 8; ++q) { acc[nb][mb][2 * q] *= bflo(sg[nb][mb][q]); acc[nb][mb][2 * q + 1] *= bfhi(sg[nb][mb][q]); }
          epi_resid_f32(acc, P.out, P.out, m0, (i >> 1) * 256, stg);
        }
      });
  }
  __syncthreads();
}

DEV void l1_inproj(const Params& P, int p) {
  GEO
  const int m0 = p * 128;
  bf16_t* hn = (bf16_t*)(P.ws + WS_HN);
  bf16_t* zz = (bf16_t*)(P.ws + WS_Z + (size_t)p * SLICE);
  panel_rmsnorm(P.out, P.norm_mix + DM, hn, m0);
  const bf16_t* wt = (const bf16_t*)(P.ws + W_IN1);
  gemm_seq<14, 14>(8, [&](int nt) { return GTile{hn + (size_t)m0 * DM, DM, wt + (size_t)nt * 256 * DM, DM, DM}; },
                   [&](int nt, f32x16 (&acc)[2][2], int stg) { epi_rows_bf16(acc, stg, [&](int tr, int cr, u32x4 v) { *(u32x4*)(zz + (size_t)tr * 2048 + nt * 256 + cr) = v; }); });
}
DEV void p4_panel(const Params& P, int p) {
  GEO
  const int m0 = p * 128, s0 = m0 % SEQ;
  bf16_t* xrc = (bf16_t*)(P.ws + WS_HN);
  const bf16_t* zz = (const bf16_t*)(P.ws + WS_Z + (size_t)p * SLICE);
  const bf16_t* zzp = (const bf16_t*)(P.ws + WS_Z + (size_t)(p - 1) * SLICE);
  bf16_t* la = (bf16_t*)(P.ws + WS_TAB + 64 * MB);
  bf16_t* ub = (bf16_t*)(P.ws + WS_Z + (size_t)p * SLICE + 512 * 1024);
  __syncthreads();
  {
    const int ch = 2 * tid;
    const float w0a = P.odd_conv_w[ch], w0b = P.odd_conv_w[ch + 1], w1a = P.odd_conv_w[1024 + ch], w1b = P.odd_conv_w[1025 + ch];
    const float w2a = P.odd_conv_w[2048 + ch], w2b = P.odd_conv_w[2049 + ch], w3a = P.odd_conv_w[3072 + ch], w3b = P.odd_conv_w[3073 + ch];
    const float cba = P.odd_conv_b[ch], cbb = P.odd_conv_b[ch + 1];
    float x3a = 0.f, x3b = 0.f, x2a = 0.f, x2b = 0.f, x1a = 0.f, x1b = 0.f;
    if (s0 > 0) {
      const unsigned h3 = *(const unsigned*)(zzp + (size_t)125 * 2048 + 1024 + ch), h2 = *(const unsigned*)(zzp + (size_t)126 * 2048 + 1024 + ch), h1 = *(const unsigned*)(zzp + (size_t)127 * 2048 + 1024 + ch);
      x3a = bflo(h3); x3b = bfhi(h3); x2a = bflo(h2); x2b = bfhi(h2); x1a = bflo(h1); x1b = bfhi(h1);
    }
#pragma nounroll
    for (int tb = 0; tb < 128; tb += 32) {
      unsigned xv[32];
#pragma unroll
      for (int i = 0; i < 32; ++i) xv[i] = *(const unsigned*)(zz + (size_t)(tb + i) * 2048 + 1024 + ch);
#pragma unroll
      for (int i = 0; i < 32; ++i) {
        const float x0a = bflo(xv[i]), x0b = bfhi(xv[i]);
        *(unsigned*)(xrc + (size_t)(m0 + tb + i) * DM + ch) = pk2(w0a * x3a + w1a * x2a + w2a * x1a + w3a * x0a + cba, w0b * x3b + w1b * x2b + w2b * x1b + w3b * x0b + cbb);
        x3a = x2a; x2a = x1a; x1a = x0a; x3b = x2b; x2b = x1b; x1b = x0b;
      }
    }
  }
  __syncthreads();
  const bf16_t* wax = (const bf16_t*)(P.ws + W_AX);
  gemm_seq<22, 22>(8, [&](int h) { return GTile{xrc + (size_t)m0 * DM + h * 128, DM, wax + (size_t)h * 256 * 128, 128, 128}; }, [&](int h, f32x16 (&acc)[2][2], int) {
    u32x2 xrl[4][2];
#pragma unroll
    for (int rq = 0; rq < 4; ++rq)
#pragma unroll
      for (int mb = 0; mb < 2; ++mb) xrl[rq][mb] = *(const u32x2*)(xrc + (size_t)(m0 + 64 * wm + 32 * mb + l32) * DM + h * 128 + 32 * wn + 8 * rq + 4 * hi);
#pragma unroll
    for (int rq = 0; rq < 4; ++rq) {
      const int ch = h * 128 + 32 * wn + 8 * rq + 4 * hi;
      const f32x4 ba = *(const f32x4*)(P.odd_b_a + ch), bx = *(const f32x4*)(P.odd_b_x + ch), sp = *(const f32x4*)((const float*)(P.ws + WS_PTOT + 196608) + ch);
#pragma unroll
      for (int mb = 0; mb < 2; ++mb) {
        const int tr = 64 * wm + 32 * mb + l32; const size_t tok = (size_t)(m0 + tr);
        const u32x2 xr = xrl[rq][mb];
        const float xv[4] = {bflo(xr[0]), bfhi(xr[0]), bflo(xr[1]), bfhi(xr[1])};
        float lav[4], uv[4];
#pragma unroll
        for (int e = 0; e < 4; ++e) {
          const float rg = sigmoidf_(acc[0][mb][4 * rq + e] + ba[e]), ig = sigmoidf_(acc[1][mb][4 * rq + e] + bx[e]);
          lav[e] = -8.f * rg * sp[e];
          uv[e] = __builtin_amdgcn_sqrtf(neg_expm1(2.f * lav[e])) * (ig * xv[e]);
        }
        u32x2 o1, o2; o1[0] = pk2(lav[0], lav[1]); o1[1] = pk2(lav[2], lav[3]); o2[0] = pk2(uv[0], uv[1]); o2[1] = pk2(uv[2], uv[3]);
        *(u32x2*)(la + tok * DM + ch) = o1;
        *(u32x2*)(ub + (size_t)tr * DM + ch) = o2;
      }
    }
  });
  __syncthreads();
  float* aprod = (float*)(P.ws + WS_APROD); float* hend = (float*)(P.ws + WS_HEND);
  {
    const int ch = 2 * tid;
    float Asa = 0.f, Asb = 0.f, Ha = 0.f, Hb = 0.f;
#pragma nounroll
    for (int tb = 0; tb < 128; tb += 32) {
      unsigned lv[32], uv[32];
#pragma unroll
      for (int i = 0; i < 32; ++i) { lv[i] = *(const unsigned*)(la + (size_t)(m0 + tb + i) * DM + ch); uv[i] = *(const unsigned*)(ub + (size_t)(tb + i) * DM + ch); }
#pragma unroll
      for (int i = 0; i < 32; ++i) {
        const float la_a = bflo(lv[i]), la_b = bfhi(lv[i]);
        Ha = __expf(la_a) * Ha + bflo(uv[i]); Hb = __expf(la_b) * Hb + bfhi(uv[i]); Asa += la_a; Asb += la_b;
      }
    }
    f32x2_t ao = {__expf(Asa), __expf(Asb)}, ho = {Ha, Hb};
    *(f32x2_t*)(aprod + p * DM + ch) = ao; *(f32x2_t*)(hend + p * DM + ch) = ho;
  }
}
DEV void p5_pre(const Params& P, int p) {
  GEO
  const int m0 = p * 128;
  const int pfirst = (p >> 7) << 7;
  const float* aprod = (const float*)(P.ws + WS_APROD); const float* hend = (const float*)(P.ws + WS_HEND);
  const bf16_t* la = (const bf16_t*)(P.ws + WS_TAB + 64 * MB);
  const bf16_t* ub = (const bf16_t*)(P.ws + WS_Z + (size_t)p * SLICE + 512 * 1024);
  const bf16_t* zz = (const bf16_t*)(P.ws + WS_Z + (size_t)p * SLICE);
  bf16_t* y = (bf16_t*)(P.ws + WS_HN);
  __syncthreads();
  {
    const int ch = 2 * tid;
    float Ha = 0.f, Hb = 0.f;
#pragma unroll 8
    for (int pp = pfirst; pp < p; ++pp) {
      const f32x2_t a2 = *(const f32x2_t*)(aprod + pp * DM + ch), h2 = *(const f32x2_t*)(hend + pp * DM + ch);
      Ha = a2[0] * Ha + h2[0]; Hb = a2[1] * Hb + h2[1];
    }
#pragma nounroll
    for (int tb = 0; tb < 128; tb += 32) {
      unsigned lv[32], uv[32], gv[32];
#pragma unroll
      for (int i = 0; i < 32; ++i) { lv[i] = *(const unsigned*)(la + (size_t)(m0 + tb + i) * DM + ch); uv[i] = *(const unsigned*)(ub + (size_t)(tb + i) * DM + ch); gv[i] = *(const unsigned*)(zz + (size_t)(tb + i) * 2048 + ch); }
#pragma unroll
      for (int i = 0; i < 32; ++i) {
        Ha = __expf(bflo(lv[i])) * Ha + bflo(uv[i]); Hb = __expf(bfhi(lv[i])) * Hb + bfhi(uv[i]);
        *(unsigned*)(y + (size_t)(m0 + tb + i) * DM + ch) = pk2(Ha * gelu_tanh(bflo(gv[i])), Hb * gelu_tanh(bfhi(gv[i])));
      }
    }
  }
  __syncthreads();
}


#define XB_TMO      128
#define XB_XCNT(j)  (256  + 64 * (j))
#define XB_XSUB(j)  (1280 + 64 * (j))
#define XB_XGEN(j)  (2304 + 64 * (j))
#define XB_TOP      3328
#define XB_TOPGEN   3392
#define XCD_BAR_WORDS 3456
#define XB_SPIN_CAP (1u << 18)
#define LAS3 __attribute__((address_space(3)))
DEV unsigned xb_ld(unsigned* p) { return __hip_atomic_load(p, __ATOMIC_RELAXED, __HIP_MEMORY_SCOPE_AGENT); }
DEV unsigned xb_add(unsigned* p, unsigned v) { return __hip_atomic_fetch_add(p, v, __ATOMIC_RELAXED, __HIP_MEMORY_SCOPE_AGENT); }
DEV unsigned xb_xcc_id() { return (unsigned)__builtin_amdgcn_s_getreg((3 << 11) | 20) & 0xFu; }
#define XB_SPIN(cond, bar) do { unsigned _sp = 0; while (cond) { __builtin_amdgcn_s_sleep(1); \
    if ((++_sp & 255u) == 0u) { if (xb_ld(&(bar)[XB_TMO])) break; if (_sp > XB_SPIN_CAP) { atomicAdd(&(bar)[XB_TMO], 1u); break; } } } } while (0)
struct XcdBarrier { unsigned* bar; unsigned x; volatile LAS3 unsigned* st; };
DEV XcdBarrier xcd_barrier_post(unsigned* bar, volatile LAS3 unsigned* st) {
  XcdBarrier b; b.bar = bar; b.x = xb_xcc_id(); b.st = st;
  if (threadIdx.x == 0) (void)xb_add(&bar[XB_XCNT(b.x)], 1u);
  return b;
}
DEV void xcd_barrier_complete(unsigned* bar, unsigned x, unsigned& nloc, unsigned& nx) {
  const unsigned G = gridDim.x * gridDim.y * gridDim.z;
  unsigned sum, cnt, mine, sp = 0u;
  for (;;) {
    sum = 0u; cnt = 0u; mine = 0u;
#pragma unroll
    for (unsigned j = 0; j < 16; ++j) { const unsigned c = xb_ld(&bar[XB_XCNT(j)]); sum += c; cnt += (c > 0u) ? 1u : 0u; mine = (j == x) ? c : mine; }
    if (sum == G) break;
    __builtin_amdgcn_s_sleep(1);
    if ((++sp & 255u) == 0u) { if (xb_ld(&bar[XB_TMO])) break; if (sp > XB_SPIN_CAP) { atomicAdd(&bar[XB_TMO], 1u); break; } }
  }
  nloc = mine > 0u ? mine : 1u; nx = cnt > 0u ? cnt : 1u;
}
DEV void xcd_barrier(const XcdBarrier& b) {
  asm volatile("s_waitcnt vmcnt(0)" ::: "memory");
  __syncthreads();
  if (threadIdx.x == 0) {
    unsigned* bar = b.bar;
    __builtin_amdgcn_s_waitcnt(0);
    unsigned nloc = b.st[0], nx = b.st[1];
    if (nloc == 0u) { xcd_barrier_complete(bar, b.x, nloc, nx); b.st[0] = nloc; b.st[1] = nx; }
    const unsigned old = xb_add(&bar[XB_XSUB(b.x)], 1u);
    const unsigned gen = old / nloc;
    if (old + 1u == (gen + 1u) * nloc) {
      __builtin_amdgcn_fence(__ATOMIC_RELEASE, "agent");
      asm volatile("s_waitcnt vmcnt(0)" ::: "memory");
      const unsigned og = xb_add(&bar[XB_TOP], 1u);
      const unsigned tg = og / nx;
      if (og + 1u == (tg + 1u) * nx) xb_add(&bar[XB_TOPGEN], 1u);
      else XB_SPIN(xb_ld(&bar[XB_TOPGEN]) == tg, bar);
      __builtin_amdgcn_fence(__ATOMIC_ACQUIRE, "agent");
      xb_add(&bar[XB_XGEN(b.x)], 1u);
      asm volatile("s_waitcnt vmcnt(0)" ::: "memory");
    } else {
      XB_SPIN(xb_ld(&bar[XB_XGEN(b.x)]) == gen, bar);
      __builtin_amdgcn_fence(__ATOMIC_ACQUIRE, "agent");
      asm volatile("s_waitcnt vmcnt(0)" ::: "memory");
    }
  }
  __syncthreads();
}
__global__ void __launch_bounds__(512) mega(Params P) {
  cg::grid_group grid = cg::this_grid();
  const int tid = threadIdx.x;
  unsigned char* ws = P.ws;
  volatile LAS3 unsigned* xst = (volatile LAS3 unsigned*)(smem + LDS_BYTES - 64);
  if (tid == 0) { xst[0] = 0u; xst[1] = 0u; xst[2] = 0u; xst[3] = 0u; }
  __syncthreads();
  const XcdBarrier xbar = xcd_barrier_post((unsigned*)(ws + WS_PTOT + 131072), xst);
  STAMP(0);
  if (blockIdx.x == 0 && tid == 0) { *(unsigned*)(ws + WS_PTOT + 65536) = 0u; *(unsigned*)(ws + WS_PTOT + 65536 + 64) = 0u; }
  transpose_job(P.even_w_in, 1024, 3072, 3080, (bf16_t*)(ws + W_IN0), 1024);
  transpose_job(P.even_w_out, 1024, 1024, 1024, (bf16_t*)(ws + W_OUT0), 1024);
  transpose_job(P.odd_w_in, 1024, 2048, 2048, (bf16_t*)(ws + W_IN1), 1024);
  transpose_job(P.odd_w_out, 1024, 1024, 1024, (bf16_t*)(ws + W_OUT1), 1024);
#pragma nounroll
  for (int l = 0; l < 2; ++l) {
    transpose_job(P.ple_up + (size_t)l * 256 * 1024, 256, 1024, 1024, (bf16_t*)(ws + W_UP) + (size_t)l * 1024 * 256, 256);
    transpose_job(P.ple_gate + (size_t)l * 1024 * 1024, 1024, 1024, 1024, (bf16_t*)(ws + W_GATE) + (size_t)l * 1024 * 1024, 1024);
  }
  convert_job(P.peer_wq, (bf16_t*)(ws + W_QB), (size_t)2 * 1024 * 2048);
  {
    const int gsz = gridDim.x * 512, gid = blockIdx.x * 512 + tid;
    bf16_t* bsk = (bf16_t*)(ws + W_SK);
    for (int i = gid; i < 2 * 65536; i += gsz) {
      const int l = i >> 16, n = (i >> 8) & 255, k = i & 255;
      float v = 0.f;
      if ((n < 128) == (k < 128)) v = P.peer_sk[(size_t)l * 32768 + (size_t)(n >> 7) * 16384 + (n & 127) * 128 + (k & 127)];
      bsk[i] = f2bf(v);
    }
    float* spt = (float*)(ws + WS_PTOT + 196608);
    for (int i = gid; i < 1024; i += gsz) { const float nl = -P.odd_lru[i]; spt[i] = fmaxf(nl, 0.f) + log1pf(__expf(-fabsf(nl))); }
    bf16_t* wax = (bf16_t*)(ws + W_AX);
    for (int i = gid; i < 8 * 256 * 128; i += gsz) {
      const int h = i >> 15, n = (i >> 7) & 255, k = i & 127;
      const int wn = n >> 6, nb = (n >> 5) & 1, jj = n & 31;
      const float* src = nb ? P.odd_w_x : P.odd_w_a;
      wax[i] = f2bf(src[(size_t)h * 16384 + k * 128 + 32 * wn + jj]);
    }
  }
  grid.sync(); STAMP(1);
#pragma nounroll
  for (int p = blockIdx.x; p < NPANEL; p += gridDim.x) { asm volatile("" ::: "memory"); p1_panel(P, p); }
#pragma nounroll
  for (int u = blockIdx.x; u < 128; u += gridDim.x) { asm volatile("" ::: "memory"); fold_unit(P, u); }
  xcd_barrier(xbar); STAMP(2);
  {
    int* hs = (int*)(smem + AT_SUF + 1024 + 64);
    unsigned* ctr = (unsigned*)(ws + WS_PTOT + 65536);
    if (tid < 8) {
      const float mine = P.even_b_forget[tid]; int rank = 0;
      for (int j = 0; j < 8; ++j) { const float o = P.even_b_forget[j]; rank += (o < mine || (o == mine && j < tid)) ? 1 : 0; }
      hs[rank] = tid;
    }
    {
      const float* ptot = (const float*)(ws + WS_PTOT);
      float* offt = (float*)(smem + AT_OFF);
      const int seq = tid >> 5, l5 = tid & 31, bb = seq >> 3, hh_ = seq & 7;
      float v0 = ptot[(bb * 128 + 4 * l5 + 0) * 8 + hh_], v1 = ptot[(bb * 128 + 4 * l5 + 1) * 8 + hh_], v2 = ptot[(bb * 128 + 4 * l5 + 2) * 8 + hh_], v3 = ptot[(bb * 128 + 4 * l5 + 3) * 8 + hh_];
      const float tot = (v0 + v1) + (v2 + v3);
      float inc = tot;
#pragma unroll
      for (int o_ = 1; o_ < 32; o_ <<= 1) { const float nb_ = __shfl_up(inc, o_, 32); if (l5 >= o_) inc += nb_; }
      const float ex = inc - tot;
      offt[seq * 128 + 4 * l5 + 0] = ex; offt[seq * 128 + 4 * l5 + 1] = ex + v0; offt[seq * 128 + 4 * l5 + 2] = ex + v0 + v1; offt[seq * 128 + 4 * l5 + 3] = ex + v0 + v1 + v2;
    }
#pragma nounroll
    for (;;) {
      __syncthreads();
      if (tid == 0) hs[8] = (int)atomicAdd(ctr, 1u);
      __syncthreads();
      const int u = hs[8];
      if (u >= 2048) break;
      const int qb = 127 - (u >> 4), bh = u & 15, b = bh >> 3;
      const int hh = hs[7 - (bh & 7)];
      asm volatile("" ::: "memory");
      attn_unit(P, b, qb, hh);
    }
    unsigned* ctr2 = ctr + 16;
#pragma nounroll
    for (;;) {
      __syncthreads();
      if (tid == 0) hs[8] = (int)atomicAdd(ctr2, 1u);
      __syncthreads();
      const int c = hs[8];
      if (c >= 2560) break;
      if (c < 2048) {
        const int t = c >> 9; const size_t off = (size_t)(c & 511) * 32768;
        const float* src = ((t & 1) ? P.peer_v : P.peer_u) + (size_t)(t >> 1) * 16384 * 1024 + off;
        unsigned char* dst = ws + WS_TAB + (size_t)t * 16 * MB + off;
#pragma unroll
        for (int it = 0; it < 4; ++it) {
          const size_t i = (size_t)(it * 512 + tid) * 16;
          u32x4 o;
#pragma unroll
          for (int q = 0; q < 4; ++q) {
            const f32x4 a = *(const f32x4*)(src + i + 4 * q);
            int d = __builtin_amdgcn_cvt_pk_fp8_f32(a[0] * 64.f, a[1] * 64.f, 0, false);
            d = __builtin_amdgcn_cvt_pk_fp8_f32(a[2] * 64.f, a[3] * 64.f, d, true);
            o[q] = (unsigned)d;
          }
          *(u32x4*)(dst + i) = o;
        }
      } else {
        const size_t off = (size_t)(c - 2048) * 32768;
        const float* src = P.p + off; bf16_t* dst = (bf16_t*)(ws + WS_PB) + off;
#pragma unroll
        for (int it = 0; it < 8; ++it) {
          const size_t i = (size_t)(it * 512 + tid) * 8;
          const f32x4 a = *(const f32x4*)(src + i), b2 = *(const f32x4*)(src + i + 4);
          u32x4 o; o[0] = pk2(a[0], a[1]); o[1] = pk2(a[2], a[3]); o[2] = pk2(b2[0], b2[1]); o[3] = pk2(b2[2], b2[3]);
          *(u32x4*)(dst + i) = o;
        }
      }
    }
  }
#pragma nounroll
  for (int p = blockIdx.x; p < NPANEL; p += gridDim.x) { asm volatile("" ::: "memory"); conv_mixer(P, p); }
  xcd_barrier(xbar); STAMP(3);
#pragma nounroll
  for (int p = blockIdx.x; p < NPANEL; p += gridDim.x) {
    Params Q = P; asm volatile("" : "+s"(Q.ws), "+s"(Q.out) :: "memory");
    resid_gemm(Q, p * 128, (const bf16_t*)(Q.ws + WS_HN), (const bf16_t*)(Q.ws + W_OUT0), Q.x);
    STAMP(10);
    chain_peer_ple(Q, 0, p);
    STAMP(14);
    l1_inproj(Q, p);
    STAMP(15);
  }
  xcd_barrier(xbar); STAMP(4);
#pragma nounroll
  for (int p = blockIdx.x; p < NPANEL; p += gridDim.x) { asm volatile("" ::: "memory"); p4_panel(P, p); }
  xcd_barrier(xbar); STAMP(5);
#pragma nounroll
  for (int p = blockIdx.x; p < NPANEL; p += gridDim.x) {
    Params Q = P; asm volatile("" : "+s"(Q.ws), "+s"(Q.out) :: "memory");
    p5_pre(Q, p);
    STAMP(18);
    resid_gemm(Q, p * 128, (const bf16_t*)(Q.ws + WS_HN), (const bf16_t*)(Q.ws + W_OUT1), Q.out);
    chain_peer_ple(Q, 1, p);
  }
#ifdef PROBE_TS
  STAMP(6);
  if (blockIdx.x == 0 && tid == 0) {
    const unsigned long long d = (g_ts[PROBE_A1] - g_ts[PROBE_A0]) * PROBE_MULT;
    const unsigned long long t0 = __builtin_amdgcn_s_memrealtime();
    while (__builtin_amdgcn_s_memrealtime() - t0 < d) __builtin_amdgcn_s_sleep(16);
  }
#endif
}

extern "C" void kernel_launch(void* const* d_in, const int* in_sizes, int n_in, void* d_out, int out_size, void* d_ws, size_t ws_size, hipStream_t stream) {
  static int grid_blocks = 0;
  if (grid_blocks == 0) {
    if (n_in != 26 || ws_size < WS_END) { fprintf(stderr, "kernel_launch: unexpected n_in %d / ws_size %zu\n", n_in, ws_size); grid_blocks = -1; return; }
    int dev = 0, cus = 0, per_cu = 0;
    (void)hipGetDevice(&dev);
    (void)hipDeviceGetAttribute(&cus, hipDeviceAttributeMultiprocessorCount, dev);
    (void)hipFuncSetAttribute((const void*)mega, hipFuncAttributeMaxDynamicSharedMemorySize, LDS_BYTES);
    (void)hipOccupancyMaxActiveBlocksPerMultiprocessor(&per_cu, (const void*)mega, 512, LDS_BYTES);
    if (per_cu < 1) { fprintf(stderr, "kernel_launch: occupancy query reports 0 blocks per CU\n"); grid_blocks = -1; return; }
    grid_blocks = cus;
    if (grid_blocks > 256) grid_blocks = 256;
  }
  if (grid_blocks < 0) return;
  (void)hipMemsetAsync((unsigned char*)d_ws + WS_PTOT + 131072, 0, 16384, stream);
  Params P{};
  const float** pp = (const float**)&P;
  for (int i = 0; i < 26; ++i) pp[i] = (const float*)d_in[i];
  P.out = (float*)d_out; P.ws = (unsigned char*)d_ws;
  void* args[] = {&P};
  hipError_t e = hipLaunchCooperativeKernel((const void*)mega, dim3(grid_blocks), dim3(512), args, LDS_BYTES, stream);
  if (e != hipSuccess) fprintf(stderr, "cooperative launch failed: %s (grid %d)\n", hipGetErrorString(e), grid_blocks);
}
```

```cpp
#include <hip/hip_runtime.h>
#include <hip/hip_cooperative_groups.h>
#include <stdint.h>
#include <cstdio>
namespace cg = cooperative_groups;

typedef unsigned short bf16_t;
typedef short bf16x8 __attribute__((ext_vector_type(8)));
typedef float f32x16 __attribute__((ext_vector_type(16)));
typedef float f32x4 __attribute__((ext_vector_type(4)));
typedef unsigned u32x4 __attribute__((ext_vector_type(4)));
typedef unsigned u32x2 __attribute__((ext_vector_type(2)));
typedef float f32x2_t __attribute__((ext_vector_type(2)));
typedef __bf16 bf16x2_t __attribute__((ext_vector_type(2)));
#define DEV __device__ __forceinline__

constexpr int T_TOK = 32768, SEQ = 16384, DM = 1024, NPANEL = 256;
constexpr float EPS = 1e-6f, LOG2E = 1.4426950408889634f;
constexpr size_t MB = 1u << 20;
constexpr size_t WS_FLOC = 0;
constexpr size_t WS_PTOT = 1 * MB;
constexpr size_t WS_APROD = 2 * MB;
constexpr size_t WS_HEND = 3 * MB;
constexpr size_t WS_W = 4 * MB;
constexpr size_t W_IN0 = WS_W, W_OUT0 = WS_W + 6 * MB, W_IN1 = WS_W + 8 * MB, W_AX = WS_W + 12 * MB, W_OUT1 = WS_W + 13 * MB,
                 W_QB = WS_W + 15 * MB, W_SK = WS_W + 23 * MB, W_PT = WS_W + 24 * MB, W_UP = WS_W + 32 * MB, W_GATE = WS_W + 33 * MB;
constexpr size_t WS_TAB = 44 * MB;
constexpr size_t WS_PB = 172 * MB;
constexpr size_t WS_HN = 204 * MB;
constexpr size_t WS_Z = 268 * MB;
constexpr size_t WS_VT = 460 * MB;
constexpr size_t WS_END = 492 * MB;
constexpr size_t SLICE = 768 * 1024;

constexpr int LROW = 144;
constexpr int GS_A = 0, GS_B = 16384, GS_STAGE = 49152;
constexpr int LDS_MISC = 3 * GS_STAGE;
constexpr int LDS_BYTES = 163840;
typedef __attribute__((address_space(3))) unsigned lds_u32;

extern __shared__ __attribute__((aligned(16))) unsigned char smem[];
#ifdef PROBE_TS
__device__ unsigned long long g_ts[32];
#define STAMP(k) do { if (blockIdx.x == 0 && threadIdx.x == 0) g_ts[k] = __builtin_amdgcn_s_memrealtime(); } while (0)
#else
#define STAMP(k) do {} while (0)
#endif


struct Params {
  const float *x, *p, *norm_mix, *norm_ffn, *norm_ple, *even_w_in, *even_b_forget, *even_conv_w, *even_q_gain, *even_k_gain, *even_w_out,
      *odd_w_in, *odd_conv_w, *odd_conv_b, *odd_w_a, *odd_b_a, *odd_w_x, *odd_b_x, *odd_lru, *odd_w_out,
      *peer_wq, *peer_sk, *peer_u, *peer_v, *ple_up, *ple_gate;
  float* out; unsigned char* ws;
};

DEV unsigned pk2(float lo, float hi) { f32x2_t v = {lo, hi}; bf16x2_t b = __builtin_convertvector(v, bf16x2_t); return __builtin_bit_cast(unsigned, b); }
DEV float bflo(unsigned u) { return __uint_as_float(u << 16); }
DEV float bfhi(unsigned u) { return __uint_as_float(u & 0xffff0000u); }
DEV float bf2f(bf16_t v) { return __uint_as_float((unsigned)v << 16); }
DEV bf16_t f2bf(float f) { return (bf16_t)(pk2(f, 0.f) & 0xffffu); }
DEV int tid_l() { int t = threadIdx.x; asm volatile("" : "+v"(t)); return t; }
DEV float wave_sum(float v) {
#pragma unroll
  for (int o = 1; o < 64; o <<= 1) v += __shfl_xor(v, o);
  return v;
}
DEV float gelu_tanh(float x) { const float u = 1.5957691216057308f * (x + 0.044715f * x * x * x); return x * __builtin_amdgcn_rcpf(1.f + __expf(-u)); }
DEV float sigmoidf_(float x) { return __builtin_amdgcn_rcpf(1.f + __expf(-x)); }
DEV float neg_expm1(float x) {
  const float pl = -x * (1.f + x * (0.5f + x * (0.16666667f + x * (0.041666668f + x * (0.008333334f + x * 0.0013888889f)))));
  return (x > -0.5f) ? pl : 1.f - __expf(x);
}

struct GTile { const bf16_t* A; int lda; const bf16_t* Bt; int ldb; int K; };
DEV int stage_next(int s) { return (s == 2 * GS_STAGE) ? 0 : s + GS_STAGE; }
template <int N> DEV void vm_wait_bar() {
  if constexpr (N >= 63) asm volatile("s_waitcnt vmcnt(63) lgkmcnt(0)" ::: "memory");
  else if constexpr (N >= 38) asm volatile("s_waitcnt vmcnt(38) lgkmcnt(0)" ::: "memory");
  else if constexpr (N >= 22) asm volatile("s_waitcnt vmcnt(22) lgkmcnt(0)" ::: "memory");
  else if constexpr (N >= 14) asm volatile("s_waitcnt vmcnt(14) lgkmcnt(0)" ::: "memory");
  else if constexpr (N >= 6) asm volatile("s_waitcnt vmcnt(6) lgkmcnt(0)" ::: "memory");
  else asm volatile("s_waitcnt vmcnt(0) lgkmcnt(0)" ::: "memory");
  __builtin_amdgcn_s_barrier(); asm volatile("" ::: "memory");
}
#define GK_SRC(t_) \
  const int lr_ = lane >> 3, lc_ = lane & 7; const char* pa[2]; const char* pb[4]; \
  _Pragma("unroll") for (int i = 0; i < 2; ++i) { const int r = 8 * (wid + 8 * i) + lr_; pa[i] = (const char*)(t_).A + ((size_t)r * (t_).lda + ((lc_ ^ ((r >> 1) & 7)) << 3)) * 2; } \
  _Pragma("unroll") for (int i = 0; i < 4; ++i) { const int r = 8 * (wid + 8 * i) + lr_; pb[i] = (const char*)(t_).Bt + ((size_t)r * (t_).ldb + ((lc_ ^ ((r >> 1) & 7)) << 3)) * 2; } \
  const int dsta = GS_A + wid * 1024, dstb = GS_B + wid * 1024;
#define GK_DMA(st_, kt_) do { \
    _Pragma("unroll") for (int i = 0; i < 2; ++i) __builtin_amdgcn_global_load_lds((const unsigned*)(pa[i] + (size_t)(kt_) * 128), (lds_u32*)(smem + (st_) + dsta + i * 8192), 16, 0, 0); \
    _Pragma("unroll") for (int i = 0; i < 4; ++i) __builtin_amdgcn_global_load_lds((const unsigned*)(pb[i] + (size_t)(kt_) * 128), (lds_u32*)(smem + (st_) + dstb + i * 8192), 16, 0, 0); } while (0)
DEV void gk_issue2(const GTile& t, int s0) {
  const int tid = tid_l(), lane = tid & 63, wid = __builtin_amdgcn_readfirstlane(tid >> 6);
  GK_SRC(t)
  asm volatile("" ::: "memory");
  GK_DMA(s0, 0);
  GK_DMA(stage_next(s0), 1);
  asm volatile("" ::: "memory");
}
template <int WAIT0>
DEV void gk_main(f32x16 (&acc)[2][2], const GTile& t, int s0) {
  const int tid = tid_l(), lane = tid & 63, wid = __builtin_amdgcn_readfirstlane(tid >> 6), wm = wid & 1, wn = wid >> 1, l32 = lane & 31, hi = lane >> 5;
  GK_SRC(t)
  const int sw = (l32 >> 1) & 7;
  int xk[4], wk[4];
#pragma unroll
  for (int ks = 0; ks < 4; ++ks) { const int ko = ((2 * ks + hi) ^ sw) << 4; xk[ks] = GS_A + (64 * wm + l32) * 128 + ko; wk[ks] = GS_B + (64 * wn + l32) * 128 + ko; }
  const int nk = t.K >> 6;
#define GK_COMPUTE(st_) do { \
    _Pragma("unroll") for (int ks = 0; ks < 4; ++ks) { \
      bf16x8 xf[2], wf[2]; \
      _Pragma("unroll") for (int mb = 0; mb < 2; ++mb) xf[mb] = *(const bf16x8*)(smem + (st_) + xk[ks] + mb * 4096); \
      _Pragma("unroll") for (int nb = 0; nb < 2; ++nb) wf[nb] = *(const bf16x8*)(smem + (st_) + wk[ks] + nb * 4096); \
      _Pragma("unroll") for (int nb = 0; nb < 2; ++nb) \
        _Pragma("unroll") for (int mb = 0; mb < 2; ++mb) acc[nb][mb] = __builtin_amdgcn_mfma_f32_32x32x16_bf16(wf[nb], xf[mb], acc[nb][mb], 0, 0, 0); } } while (0)
  vm_wait_bar<WAIT0>();
  int stc = s0, std_ = stage_next(stage_next(s0));
#pragma nounroll
  for (int kt = 0; kt < nk - 2; ++kt) {
    GK_DMA(std_, kt + 2);
    GK_COMPUTE(stc);
    vm_wait_bar<6>();
    stc = stage_next(stc); std_ = stage_next(std_);
  }
  GK_COMPUTE(stc);
  vm_wait_bar<0>();
  stc = stage_next(stc);
  GK_COMPUTE(stc);
  vm_wait_bar<0>();
#undef GK_COMPUTE
}
DEV void acc_zero(f32x16 (&acc)[2][2]);
template <int WAIT_E, int WAIT_O, class TileFn, class EpiFn>
DEV void gemm_seq(int ntiles, TileFn tf, EpiFn epi) {
  __syncthreads();
  int s0 = 0;
  GTile cur = tf(0);
  gk_issue2(cur, s0);
#pragma nounroll
  for (int i = 0; i < ntiles; ++i) {
    f32x16 acc[2][2]; acc_zero(acc);
    if (i == 0) gk_main<6>(acc, cur, s0);
    else if (i & 1) gk_main<WAIT_O>(acc, cur, s0);
    else gk_main<WAIT_E>(acc, cur, s0);
    const int sn = stage_next(s0);
    if (i + 1 < ntiles) { cur = tf(i + 1); gk_issue2(cur, sn); }
    epi(i, acc, s0);
    s0 = sn;
  }
  asm volatile("s_waitcnt vmcnt(0)" ::: "memory");
}
DEV void epi_resid_f32(const f32x16 (&acc)[2][2], const float* base, float* out, int m0, int n0, int stg) {
  const int tid = tid_l(), lane = tid & 63, wid = tid >> 6, wm = wid & 1, wn = wid >> 1, l32 = lane & 31, hi = lane >> 5;
  unsigned char* wl = smem + stg + wid * 6144;
  const size_t o0 = (size_t)(m0 + 64 * wm + (lane >> 3)) * DM + n0 + 64 * wn + (lane & 7) * 4;
  f32x4 bb[2][2][4];
#pragma unroll
  for (int mb = 0; mb < 2; ++mb)
#pragma unroll
    for (int nb = 0; nb < 2; ++nb)
#pragma unroll
      for (int it = 0; it < 4; ++it) bb[mb][nb][it] = *(const f32x4*)(base + o0 + (size_t)(32 * mb + 8 * it) * DM + 32 * nb);
#pragma unroll
  for (int mb = 0; mb < 2; ++mb)
#pragma unroll
    for (int nb = 0; nb < 2; ++nb) {
#pragma unroll
      for (int rq = 0; rq < 4; ++rq) {
        f32x4 v; v[0] = acc[nb][mb][4 * rq]; v[1] = acc[nb][mb][4 * rq + 1]; v[2] = acc[nb][mb][4 * rq + 2]; v[3] = acc[nb][mb][4 * rq + 3];
        *(f32x4*)(wl + l32 * LROW + (8 * rq + 4 * hi) * 4) = v;
      }
#pragma unroll
      for (int it = 0; it < 4; ++it) {
        const f32x4 v = *(const f32x4*)(wl + (it * 8 + (lane >> 3)) * LROW + (lane & 7) * 16);
        *(f32x4*)(out + o0 + (size_t)(32 * mb + 8 * it) * DM + 32 * nb) = v + bb[mb][nb][it];
      }
    }
}
template <class F> DEV void epi_rows_bf16(const f32x16 (&acc)[2][2], int stg, F f) {
  const int tid = tid_l(), lane = tid & 63, wid = tid >> 6, wm = wid & 1, wn = wid >> 1, l32 = lane & 31, hi = lane >> 5;
  unsigned char* wl = smem + stg + wid * 6144;
#pragma unroll
  for (int mb = 0; mb < 2; ++mb) {
#pragma unroll
    for (int nb = 0; nb < 2; ++nb)
#pragma unroll
      for (int rq = 0; rq < 4; ++rq) {
        u32x2 o; o[0] = pk2(acc[nb][mb][4 * rq], acc[nb][mb][4 * rq + 1]); o[1] = pk2(acc[nb][mb][4 * rq + 2], acc[nb][mb][4 * rq + 3]);
        *(u32x2*)(wl + l32 * LROW + (32 * nb + 8 * rq + 4 * hi) * 2) = o;
      }
#pragma unroll
    for (int it = 0; it < 4; ++it) {
      const int row = it * 8 + (lane >> 3), c8 = (lane & 7) * 8;
      const u32x4 v = *(const u32x4*)(wl + row * LROW + c8 * 2);
      f(64 * wm + 32 * mb + row, 64 * wn + c8, v);
    }
  }
}
DEV void acc_zero(f32x16 (&acc)[2][2]) {
#pragma unroll
  for (int a = 0; a < 2; ++a)
#pragma unroll
    for (int b = 0; b < 2; ++b)
#pragma unroll
      for (int r = 0; r < 16; ++r) acc[a][b][r] = 0.f;
}
#define GEO const int tid = tid_l(), lane = tid & 63, wid = tid >> 6, wm = wid & 1, wn = wid >> 1, l32 = lane & 31, hi = lane >> 5; (void)wm; (void)wn; (void)l32; (void)hi; (void)lane; (void)wid;
#define FOR_ACC _Pragma("unroll") for (int nb = 0; nb < 2; ++nb) _Pragma("unroll") for (int mb = 0; mb < 2; ++mb) _Pragma("unroll") for (int rq = 0; rq < 4; ++rq)

DEV void transpose_job(const float* __restrict__ W, int K, int N, int ldw, bf16_t* Wt, int ldt) {
  float* tile = (float*)smem;
  const int tid = tid_l(); const int ntn = N >> 6, ntiles = (K >> 6) * ntn;
  for (int t = blockIdx.x; t < ntiles; t += gridDim.x) {
    const int k0 = (t / ntn) << 6, n0 = (t % ntn) << 6;
    __syncthreads();
#pragma unroll
    for (int q = 0; q < 2; ++q) {
      const int id = tid + q * 512, i = id >> 4, c4 = (id & 15) << 2;
      const f32x4 v = *(const f32x4*)(W + (size_t)(k0 + i) * ldw + n0 + c4);
      tile[i * 65 + c4 + 0] = v[0]; tile[i * 65 + c4 + 1] = v[1]; tile[i * 65 + c4 + 2] = v[2]; tile[i * 65 + c4 + 3] = v[3];
    }
    __syncthreads();
    const int n = tid >> 3, kc = (tid & 7) << 3;
    u32x4 o;
    o[0] = pk2(tile[(kc + 0) * 65 + n], tile[(kc + 1) * 65 + n]); o[1] = pk2(tile[(kc + 2) * 65 + n], tile[(kc + 3) * 65 + n]);
    o[2] = pk2(tile[(kc + 4) * 65 + n], tile[(kc + 5) * 65 + n]); o[3] = pk2(tile[(kc + 6) * 65 + n], tile[(kc + 7) * 65 + n]);
    *(u32x4*)(Wt + (size_t)(n0 + n) * ldt + k0 + kc) = o;
  }
  __syncthreads();
}
DEV void convert_job(const float* __restrict__ src, bf16_t* dst, size_t n) {
  const size_t stride = (size_t)gridDim.x * 512 * 8;
  for (size_t i = ((size_t)blockIdx.x * 512 + threadIdx.x) * 8; i < n; i += stride) {
    const f32x4 a = *(const f32x4*)(src + i), b = *(const f32x4*)(src + i + 4);
    u32x4 o; o[0] = pk2(a[0], a[1]); o[1] = pk2(a[2], a[3]); o[2] = pk2(b[0], b[1]); o[3] = pk2(b[2], b[3]);
    *(u32x4*)(dst + i) = o;
  }
}

DEV void convert_fp8_job(const float* __restrict__ src, unsigned char* dst, size_t n) {
  const size_t stride = (size_t)gridDim.x * 512 * 16;
  for (size_t i = ((size_t)blockIdx.x * 512 + threadIdx.x) * 16; i < n; i += stride) {
    u32x4 o;
#pragma unroll
    for (int q = 0; q < 4; ++q) {
      const f32x4 a = *(const f32x4*)(src + i + 4 * q);
      int d = __builtin_amdgcn_cvt_pk_fp8_f32(a[0] * 64.f, a[1] * 64.f, 0, false);
      d = __builtin_amdgcn_cvt_pk_fp8_f32(a[2] * 64.f, a[3] * 64.f, d, true);
      o[q] = (unsigned)d;
    }
    *(u32x4*)(dst + i) = o;
  }
}
DEV void panel_rmsnorm(const float* src, const float* __restrict__ gain, bf16_t* dst, int m0) {
  GEO
  f32x4 g[4];
#pragma unroll
  for (int j = 0; j < 4; ++j) g[j] = *(const f32x4*)(gain + j * 256 + lane * 4);
#pragma nounroll
  for (int i = 0; i < 16; i += 4) {
    f32x4 v[4][4];
#pragma unroll
    for (int r = 0; r < 4; ++r)
#pragma unroll
      for (int j = 0; j < 4; ++j) v[r][j] = *(const f32x4*)(src + (size_t)(m0 + wid * 16 + i + r) * DM + j * 256 + lane * 4);
#pragma unroll
    for (int r = 0; r < 4; ++r) {
      float s = 0.f;
#pragma unroll
      for (int j = 0; j < 4; ++j) s += v[r][j][0] * v[r][j][0] + v[r][j][1] * v[r][j][1] + v[r][j][2] * v[r][j][2] + v[r][j][3] * v[r][j][3];
      const float rstd = rsqrtf(wave_sum(s) * (1.f / DM) + EPS);
#pragma unroll
      for (int j = 0; j < 4; ++j) {
        u32x2 o; o[0] = pk2(v[r][j][0] * rstd * g[j][0], v[r][j][1] * rstd * g[j][1]); o[1] = pk2(v[r][j][2] * rstd * g[j][2], v[r][j][3] * rstd * g[j][3]);
        *(u32x2*)(dst + (size_t)(m0 + wid * 16 + i + r) * DM + j * 256 + lane * 4) = o;
      }
    }
  }
}

DEV void p1_panel(const Params& P, int p) {
  GEO
  const int m0 = p * 128;
  bf16_t* hn = (bf16_t*)(P.ws + WS_HN);
  bf16_t* z = (bf16_t*)(P.ws + WS_Z);
  bf16_t* vt = (bf16_t*)(P.ws + WS_VT);
  float* floc = (float*)(P.ws + WS_FLOC);
  float* ptot = (float*)(P.ws + WS_PTOT);
  float* lf = (float*)(smem + LDS_MISC);
  {
    float wfr[4][4][8]; f32x4 g[4];
#pragma unroll
    for (int j = 0; j < 4; ++j) {
      g[j] = *(const f32x4*)(P.norm_mix + j * 256 + lane * 4);
#pragma unroll
      for (int e = 0; e < 4; ++e) {
        const float* wp = P.even_w_in + (size_t)(j * 256 + lane * 4 + e) * 3080 + 3072;
        const f32x4 a = *(const f32x4*)wp, b = *(const f32x4*)(wp + 4);
        wfr[j][e][0] = a[0]; wfr[j][e][1] = a[1]; wfr[j][e][2] = a[2]; wfr[j][e][3] = a[3];
        wfr[j][e][4] = b[0]; wfr[j][e][5] = b[1]; wfr[j][e][6] = b[2]; wfr[j][e][7] = b[3];
      }
    }
#pragma nounroll
    for (int i2 = 0; i2 < 16; i2 += 2) {
      f32x4 vv[2][4];
#pragma unroll
      for (int r = 0; r < 2; ++r)
#pragma unroll
        for (int j = 0; j < 4; ++j) vv[r][j] = *(const f32x4*)(P.x + (size_t)(m0 + wid * 16 + i2 + r) * DM + j * 256 + lane * 4);
#pragma unroll
      for (int r = 0; r < 2; ++r) {
        const int i = i2 + r;
        const size_t row = (size_t)(m0 + wid * 16 + i) * DM;
        float s = 0.f;
#pragma unroll
        for (int j = 0; j < 4; ++j) s += vv[r][j][0] * vv[r][j][0] + vv[r][j][1] * vv[r][j][1] + vv[r][j][2] * vv[r][j][2] + vv[r][j][3] * vv[r][j][3];
        const float rstd = rsqrtf(wave_sum(s) * (1.f / DM) + EPS);
        float fs[8];
#pragma unroll
        for (int h = 0; h < 8; ++h) fs[h] = 0.f;
#pragma unroll
        for (int j = 0; j < 4; ++j) {
          float hv[4];
#pragma unroll
          for (int e = 0; e < 4; ++e) {
            hv[e] = vv[r][j][e] * rstd * g[j][e];
#pragma unroll
            for (int h = 0; h < 8; ++h) fs[h] += hv[e] * wfr[j][e][h];
          }
          u32x2 o; o[0] = pk2(hv[0], hv[1]); o[1] = pk2(hv[2], hv[3]);
          *(u32x2*)(hn + row + j * 256 + lane * 4) = o;
        }
#pragma unroll
        for (int h = 0; h < 8; ++h) fs[h] = wave_sum(fs[h]);
        if (lane < 8) {
          float f = fs[0];
#pragma unroll
          for (int h = 1; h < 8; ++h) f = (lane == h) ? fs[h] : f;
          const float xx = f + P.even_b_forget[lane];
          lf[(wid * 16 + i) * 8 + lane] = fminf(xx, 0.f) - log1pf(__expf(-fabsf(xx)));
        }
      }
    }
  }
  __syncthreads();
  if (tid < 8) {
    const int b = m0 / SEQ, s0 = m0 % SEQ;
    float cum = 0.f; float* fo = floc + (size_t)(b * 8 + tid) * SEQ + s0;
    for (int t = 0; t < 128; ++t) { cum += lf[t * 8 + tid]; fo[t] = cum; }
    ptot[p * 8 + tid] = cum;
  }
  const bf16_t* wt = (const bf16_t*)(P.ws + W_IN0);
  gemm_seq<14, 14>(12, [&](int nt) { return GTile{hn + (size_t)m0 * DM, DM, wt + (size_t)nt * 256 * DM, DM, DM}; }, [&](int nt, f32x16 (&acc)[2][2], int stg) {
    const int n0 = nt * 256;
    if (nt < 10) {
      if (nt >= 6) {
        const bool isq = nt < 8;
        const float* gn = isq ? P.even_q_gain : P.even_k_gain;
        const float extra = isq ? 0.125f * LOG2E : 1.f;
#pragma unroll
        for (int mb = 0; mb < 2; ++mb) {
          float s = 0.f;
#pragma unroll
          for (int nb = 0; nb < 2; ++nb)
#pragma unroll
            for (int r = 0; r < 16; ++r) s += acc[nb][mb][r] * acc[nb][mb][r];
          s += __shfl_xor(s, 32);
          const float rstd = rsqrtf(s * (1.f / 64.f) + EPS) * extra;
#pragma unroll
          for (int nb = 0; nb < 2; ++nb)
#pragma unroll
            for (int rq = 0; rq < 4; ++rq) {
              const f32x4 gg = *(const f32x4*)(gn + 32 * nb + 8 * rq + 4 * hi);
#pragma unroll
              for (int e = 0; e < 4; ++e) acc[nb][mb][4 * rq + e] *= rstd * gg[e];
            }
        }
      }
      epi_rows_bf16(acc, stg, [&](int tr, int cr, u32x4 v) { *(u32x4*)(z + (size_t)(m0 + tr) * 3072 + n0 + cr) = v; });
    } else {
      FOR_ACC {
        const int tok = m0 + 64 * wm + 32 * mb + l32, col = n0 + 64 * wn + 32 * nb + 8 * rq + 4 * hi - 2560;
        const int b = tok / SEQ, s = tok % SEQ;
#pragma unroll
        for (int e = 0; e < 4; ++e) vt[(size_t)(b * 512 + col + e) * SEQ + s] = f2bf(acc[nb][mb][4 * rq + e]);
      }
    }
  });
}
DEV void fold_unit(const Params& P, int u) {
  GEO
  const int l = u >> 6, jt = (u >> 3) & 7, hh = u & 7;
  const bf16_t* A = (const bf16_t*)(P.ws + W_QB) + (size_t)l * 1024 * 2048 + (size_t)(jt * 128) * 2048 + hh * 256;
  const bf16_t* Bt = (const bf16_t*)(P.ws + W_SK) + (size_t)l * 65536;
  bf16_t* wpt = (bf16_t*)(P.ws + W_PT);
  gemm_seq<6, 6>(1, [&](int) { return GTile{A, 2048, Bt, 256, 256}; }, [&](int, f32x16 (&acc)[2][2], int) {
    FOR_ACC {
      const int j = jt * 128 + 64 * wm + 32 * mb + l32, n = 64 * wn + 32 * nb + 8 * rq + 4 * hi;
#pragma unroll
      for (int e = 0; e < 4; ++e) wpt[((size_t)l * 2048 + hh * 256 + n + e) * 1024 + j] = f2bf(acc[nb][mb][4 * rq + e]);
    }
  });
}

constexpr int VROW = 272;
constexpr int AT_K = 0, AT_V = 128 * LROW, AT_BIAS = AT_V + 64 * VROW, AT_STG = AT_BIAS + 512;
constexpr int AT_GRP = 2 * AT_STG;
constexpr int AT_SUF = 2 * AT_GRP;
constexpr int AT_OFF = AT_SUF + 1280;
static_assert(AT_OFF + 8192 <= LDS_BYTES - 64, "attention LDS map");
DEV int crow(int r, int hi) { return 8 * (r >> 2) + 4 * hi + (r & 3); }

constexpr float SKIP_THR = 64.f;
DEV void attn_unit(const Params& P, int b, int qb, int h) {
  const int tid = tid_l(), lane = tid & 63, wid = tid >> 6, l32 = lane & 31, hi = lane >> 5;
  const int g = wid >> 2, wq = wid & 3, gt = tid & 255;
  const bf16_t* z = (const bf16_t*)(P.ws + WS_Z);
  const bf16_t* vt = (const bf16_t*)(P.ws + WS_VT);
  bf16_t* ycat = (bf16_t*)(P.ws + WS_HN);
  const float* fl = (const float*)(P.ws + WS_FLOC) + (size_t)(b * 8 + h) * SEQ;
  const float* ptot = (const float*)(P.ws + WS_PTOT);
  float* suf = (float*)(smem + AT_SUF) + g * 128;
  __syncthreads();
  {
    const float* offt = (const float*)(smem + AT_OFF) + (b * 8 + h) * 128;
    if (gt < 128) suf[gt] = (gt < qb) ? (offt[qb] - offt[gt]) : 0.f;
  }
  __syncthreads();
  const int tokq = b * SEQ + qb * 128 + wq * 32 + l32;
  bf16x8 qf[4];
#pragma unroll
  for (int d0 = 0; d0 < 4; ++d0) qf[d0] = *(const bf16x8*)(z + (size_t)tokq * 3072 + 1536 + h * 64 + d0 * 16 + hi * 8);
  const float fend = fl[qb * 128 + 127];
  const int NT = 2 * qb + 2;
  int t_start;
  {
    const float D2 = (fl[qb * 128] - fend) * LOG2E;
    int* tsl = (int*)(smem + AT_SUF + 1024);
    bool skip = false;
    if (gt < NT) { const int j = 64 * gt + 63; skip = ((fend - fl[j] + suf[j >> 7]) * LOG2E + D2 < -SKIP_THR); }
    const unsigned long long bal = __ballot(skip);
    if (lane == 0) tsl[wid] = __popcll(bal);
    __syncthreads();
    const int c0 = tsl[0] + tsl[1] + tsl[2] + tsl[3], c1 = tsl[4] + tsl[5] + tsl[6] + tsl[7];
    t_start = min(min(c0, c1), 2 * qb);
  }
  const int t_start64 = t_start;
  const int NT2 = qb + 1;
  const int ts2 = t_start64 >> 1;
  const int kc = gt & 7, kr = gt >> 3, vc = gt & 15, vr = gt >> 4;
  const bf16_t* kg = z + (size_t)(b * SEQ + kr) * 3072 + 2048 + h * 64 + kc * 8;
  const bf16_t* vg = vt + (size_t)((b * 8 + h) * 64 + vr) * SEQ + vc * 8;
  const int gbase = g * AT_GRP;
  const int sk_ = kr * LROW + kc * 16, sv_ = vr * VROW + vc * 16;
  u32x4 rk[4], rv[4]; float rbias = 0.f;
#define AT_LOAD(t) do { \
    _Pragma("unroll") for (int i_ = 0; i_ < 4; ++i_) { rk[i_] = *(const u32x4*)(kg + (size_t)((t) * 128 + 32 * i_) * 3072); rv[i_] = *(const u32x4*)(vg + (size_t)(16 * i_) * SEQ + (t) * 128); } \
    if (gt < 128) { const int j_ = (t) * 128 + gt; rbias = (fend - fl[j_] + suf[j_ >> 7]) * LOG2E; } } while (0)
#define AT_STORE(st) do { \
    _Pragma("unroll") for (int i_ = 0; i_ < 4; ++i_) { *(u32x4*)(smem + (st) + AT_K + sk_ + 32 * i_ * LROW) = rk[i_]; *(u32x4*)(smem + (st) + AT_V + sv_ + 16 * i_ * VROW) = rv[i_]; } \
    if (gt < 128) *(float*)(smem + (st) + AT_BIAS + gt * 4) = rbias; } while (0)
  const int niter = (NT2 - ts2 + 1) >> 1;
  if (ts2 + g < NT2) { AT_LOAD(ts2 + g); AT_STORE(gbase); }
  __syncthreads();
  float m = -INFINITY, l = 0.f;
  f32x16 o[2];
#pragma unroll
  for (int r = 0; r < 16; ++r) { o[0][r] = 0.f; o[1][r] = 0.f; }
#pragma nounroll
  for (int it = 0; it < niter; ++it) {
    const int t2 = ts2 + 2 * it + g;
    const int st = gbase + (it & 1) * AT_STG;
    const bool more = t2 + 2 < NT2;
    if (more) AT_LOAD(t2 + 2);
#pragma nounroll
   for (int sub = 0; sub < 2; ++sub) {
    const int t = 2 * t2 + sub;
    const bool active = (t2 < NT2) && (t >= t_start64) && !(t == 2 * qb + 1 && wq < 2);
    if (active) {
      f32x16 s0, s1;
#pragma unroll
      for (int rq = 0; rq < 4; ++rq) {
        const f32x4 b0 = *(const f32x4*)(smem + st + AT_BIAS + (64 * sub + 8 * rq + 4 * hi) * 4);
        const f32x4 b1 = *(const f32x4*)(smem + st + AT_BIAS + (64 * sub + 32 + 8 * rq + 4 * hi) * 4);
#pragma unroll
        for (int e = 0; e < 4; ++e) { s0[4 * rq + e] = b0[e]; s1[4 * rq + e] = b1[e]; }
      }
#pragma unroll
      for (int d0 = 0; d0 < 4; ++d0) {
        const bf16x8 k0 = *(const bf16x8*)(smem + st + AT_K + (64 * sub + l32) * LROW + d0 * 32 + hi * 16);
        const bf16x8 k1 = *(const bf16x8*)(smem + st + AT_K + (64 * sub + 32 + l32) * LROW + d0 * 32 + hi * 16);
        s0 = __builtin_amdgcn_mfma_f32_32x32x16_bf16(k0, qf[d0], s0, 0, 0, 0);
        s1 = __builtin_amdgcn_mfma_f32_32x32x16_bf16(k1, qf[d0], s1, 0, 0, 0);
      }
      if (t >= 2 * qb) {
        const int kb = 64 * (t - 2 * qb), qrel = 32 * wq + l32;
#pragma unroll
        for (int r = 0; r < 16; ++r) {
          const int kv = kb + crow(r, hi);
          if (kv > qrel) s0[r] = -INFINITY;
          if (kv + 32 > qrel) s1[r] = -INFINITY;
        }
      }
      float mx = s0[0];
#pragma unroll
      for (int r = 1; r < 16; ++r) mx = fmaxf(mx, s0[r]);
#pragma unroll
      for (int r = 0; r < 16; ++r) mx = fmaxf(mx, s1[r]);
      mx = fmaxf(mx, __shfl_xor(mx, 32));
      const float mn = fmaxf(m, mx);
      const float alpha = __builtin_amdgcn_exp2f(m - mn);
      m = mn;
      float ls = 0.f;
#pragma unroll
      for (int r = 0; r < 16; ++r) { s0[r] = __builtin_amdgcn_exp2f(s0[r] - mn); s1[r] = __builtin_amdgcn_exp2f(s1[r] - mn); ls += s0[r] + s1[r]; }
      l = l * alpha + ls;
      if (__any(alpha != 1.f)) {
#pragma unroll
        for (int r = 0; r < 16; ++r) { o[0][r] *= alpha; o[1][r] *= alpha; }
      }
      bf16x8 pf[2][2];
#pragma unroll
      for (int ks = 0; ks < 2; ++ks) {
        u32x4 a, c;
        a[0] = pk2(s0[8 * ks + 0], s0[8 * ks + 1]); a[1] = pk2(s0[8 * ks + 2], s0[8 * ks + 3]); a[2] = pk2(s0[8 * ks + 4], s0[8 * ks + 5]); a[3] = pk2(s0[8 * ks + 6], s0[8 * ks + 7]);
        c[0] = pk2(s1[8 * ks + 0], s1[8 * ks + 1]); c[1] = pk2(s1[8 * ks + 2], s1[8 * ks + 3]); c[2] = pk2(s1[8 * ks + 4], s1[8 * ks + 5]); c[3] = pk2(s1[8 * ks + 6], s1[8 * ks + 7]);
        pf[0][ks] = __builtin_bit_cast(bf16x8, a); pf[1][ks] = __builtin_bit_cast(bf16x8, c);
      }
#pragma unroll
      for (int pbk = 0; pbk < 2; ++pbk)
#pragma unroll
        for (int ks = 0; ks < 2; ++ks)
#pragma unroll
          for (int db = 0; db < 2; ++db) {
            const int off = st + AT_V + (32 * db + l32) * VROW + (64 * sub + 32 * pbk + 16 * ks + 4 * hi) * 2;
            const u32x2 lo = *(const u32x2*)(smem + off), hh = *(const u32x2*)(smem + off + 16);
            u32x4 vv; vv[0] = lo[0]; vv[1] = lo[1]; vv[2] = hh[0]; vv[3] = hh[1];
            o[db] = __builtin_amdgcn_mfma_f32_32x32x16_bf16(__builtin_bit_cast(bf16x8, vv), pf[pbk][ks], o[db], 0, 0, 0);
          }
    }
   }
    if (more) AT_STORE(gbase + ((it + 1) & 1) * AT_STG);
    __syncthreads();
  }
#undef AT_LOAD
#undef AT_STORE
  float* mg = (float*)(smem + AT_GRP) + (wq * 64 + lane) * 34;
  if (g == 1) {
#pragma unroll
    for (int r = 0; r < 16; ++r) { mg[r] = o[0][r]; mg[16 + r] = o[1][r]; }
    mg[32] = m; mg[33] = l;
  }
  __syncthreads();
  if (g == 0) {
    const float m1 = mg[32], l1 = mg[33];
    const float ms = fmaxf(m, m1);
    const float f0 = __builtin_amdgcn_exp2f(m - ms), f1 = __builtin_amdgcn_exp2f(m1 - ms);
    l = l * f0 + l1 * f1;
#pragma unroll
    for (int r = 0; r < 16; ++r) { o[0][r] = o[0][r] * f0 + mg[r] * f1; o[1][r] = o[1][r] * f0 + mg[16 + r] * f1; }
    l += __shfl_xor(l, 32);
    const float inv = 1.f / l;
#pragma unroll
    for (int db = 0; db < 2; ++db)
#pragma unroll
      for (int rq = 0; rq < 4; ++rq) {
        u32x2 ov; ov[0] = pk2(o[db][4 * rq] * inv, o[db][4 * rq + 1] * inv); ov[1] = pk2(o[db][4 * rq + 2] * inv, o[db][4 * rq + 3] * inv);
        *(u32x2*)(ycat + (size_t)tokq * DM + 512 + h * 64 + 32 * db + 8 * rq + 4 * hi) = ov;
      }
  }
}
DEV void conv_mixer(const Params& P, int p) {
  const int tid = tid_l(), c = 2 * (tid & 255), t0 = p * 128 + 64 * (tid >> 8);
  const bf16_t* z = (const bf16_t*)(P.ws + WS_Z);
  bf16_t* ycat = (bf16_t*)(P.ws + WS_HN);
  const float w0a = P.even_conv_w[c], w0b = P.even_conv_w[c + 1], w1a = P.even_conv_w[512 + c], w1b = P.even_conv_w[513 + c], w2a = P.even_conv_w[1024 + c], w2b = P.even_conv_w[1025 + c];
  float g2a = 0.f, g2b = 0.f, g1a = 0.f, g1b = 0.f;
  if (t0 % SEQ != 0) {
    const bf16_t* r2 = z + (size_t)(t0 - 2) * 3072, *r1 = z + (size_t)(t0 - 1) * 3072;
    const unsigned c2 = *(const unsigned*)(r2 + 512 + c), x2 = *(const unsigned*)(r2 + 1024 + c), c1 = *(const unsigned*)(r1 + 512 + c), x1 = *(const unsigned*)(r1 + 1024 + c);
    g2a = bflo(c2) * bflo(x2); g2b = bfhi(c2) * bfhi(x2); g1a = bflo(c1) * bflo(x1); g1b = bfhi(c1) * bfhi(x1);
  }
#pragma nounroll
  for (int tb = 0; tb < 64; tb += 32) {
    unsigned gb[32], gc[32], xa[32];
#pragma unroll
    for (int i = 0; i < 32; ++i) { const bf16_t* r = z + (size_t)(t0 + tb + i) * 3072 + c; gb[i] = *(const unsigned*)r; gc[i] = *(const unsigned*)(r + 512); xa[i] = *(const unsigned*)(r + 1024); }
#pragma unroll
    for (int i = 0; i < 32; ++i) {
      const float g0a = bflo(gc[i]) * bflo(xa[i]), g0b = bfhi(gc[i]) * bfhi(xa[i]);
      const float ya = bflo(gb[i]) * (w0a * g2a + w1a * g1a + w2a * g0a), yb = bfhi(gb[i]) * (w0b * g2b + w1b * g1b + w2b * g0b);
      *(unsigned*)(ycat + (size_t)(t0 + tb + i) * DM + c) = pk2(ya, yb);
      g2a = g1a; g1a = g0a; g2b = g1b; g1b = g0b;
    }
  }
}

DEV unsigned fkey(float x) { const unsigned u = __float_as_uint(x); return (u & 0x80000000u) ? ~u : (u | 0x80000000u); }
DEV float keyf(unsigned k) { const unsigned u = (k & 0x80000000u) ? (k & 0x7fffffffu) : ~k; return __uint_as_float(u); }
DEV void cswap(unsigned& a, unsigned& b) { const unsigned hi_ = max(a, b), lo_ = min(a, b); a = hi_; b = lo_; }
DEV void bitonic_merge16_desc(unsigned (&v)[16]) {
#pragma unroll
  for (int j = 8; j >= 1; j >>= 1)
#pragma unroll
    for (int i = 0; i < 16; ++i) { const int l = i ^ j; if (l > i) cswap(v[i], v[l]); }
}
DEV void bitonic_sort16_desc(unsigned (&v)[16]) {
#pragma unroll
  for (int k = 2; k <= 16; k <<= 1)
#pragma unroll
    for (int j = k >> 1; j >= 1; j >>= 1)
#pragma unroll
      for (int i = 0; i < 16; ++i) { const int l = i ^ j; if (l > i) { if ((i & k) == 0) cswap(v[i], v[l]); else cswap(v[l], v[i]); } }
}
DEV void merge_top16(unsigned (&R)[16], const unsigned (&G)[16]) {
#pragma unroll
  for (int i = 0; i < 16; ++i) R[i] = max(R[i], G[15 - i]);
  bitonic_merge16_desc(R);
}
DEV void stage1(unsigned (&L)[16], const float* sp) {
  float sv[128];
#pragma unroll
  for (int i = 0; i < 128; ++i) sv[i] = sp[(size_t)i * 128];
#pragma unroll
  for (int i = 0; i < 128; i += 16) {
    unsigned g[16];
#pragma unroll
    for (int e = 0; e < 16; ++e) g[e] = (fkey(sv[i + e]) & ~127u) | (unsigned)(127 - (i + e));
    bitonic_sort16_desc(g);
    if (i == 0) {
#pragma unroll
      for (int e = 0; e < 16; ++e) L[e] = g[e];
    } else merge_top16(L, g);
  }
}
DEV void topk_group(int hg, const float* scoresT, int* idxo, float* go) {
  const int tid = tid_l(), token = tid & 127, hl = tid >> 7;
  unsigned LA[16], LB[16], LC[16];
  stage1(LA, scoresT + (size_t)(hl * 256) * 128 + token);
  stage1(LB, scoresT + (size_t)(hl * 256 + 128) * 128 + token);
  unsigned* la = (unsigned*)smem; unsigned* lb = la + 16 * 512;
  float bv[16];
#pragma unroll
  for (int j = 0; j < 16; ++j) { bv[j] = keyf(LB[j] & ~127u); la[j * 512 + tid] = LA[j]; lb[j * 512 + tid] = LB[j]; }
  {
    constexpr int CI[64] = {0,0,0,0,0,0,0,0,0,0,0,0,0,0,0,0, 1,1,1,1,1,1,1,1, 2,2,2,2,2, 3,3,3,3, 4,4,4, 5,5, 6,6, 7,7, 8,9,10,11,12,13,14,15, 0,0,0,0,0,0,0,0,0,0,0,0,0,0};
    constexpr int CJ[64] = {0,1,2,3,4,5,6,7,8,9,10,11,12,13,14,15, 0,1,2,3,4,5,6,7, 0,1,2,3,4, 0,1,2,3, 0,1,2, 0,1, 0,1, 0,1, 0,0,0,0,0,0,0,0, 0,0,0,0,0,0,0,0,0,0,0,0,0,0};
    float av[16];
#pragma unroll
    for (int i = 0; i < 16; ++i) av[i] = keyf(LA[i] & ~127u);
#pragma unroll
    for (int gq = 0; gq < 4; ++gq) {
      unsigned g[16];
#pragma unroll
      for (int e = 0; e < 16; ++e) {
        const int ci = CI[gq * 16 + e], cj = CJ[gq * 16 + e];
        g[e] = (gq * 16 + e < 50) ? ((fkey(av[ci] + bv[cj]) & ~255u) | (unsigned)(255 - (ci * 16 + cj))) : 0u;
      }
      bitonic_sort16_desc(g);
      if (gq == 0) {
#pragma unroll
        for (int e = 0; e < 16; ++e) LC[e] = g[e];
      } else merge_top16(LC, g);
    }
  }
  const float smax = keyf(LC[0] & ~255u);
  float ev[16], sum = 0.f;
#pragma unroll
  for (int k = 0; k < 16; ++k) { ev[k] = __expf(keyf(LC[k] & ~255u) - smax); sum += ev[k]; }
  const float inv = 1.f / sum;
  const int head = hg * 4 + hl;
#pragma unroll
  for (int k = 0; k < 16; ++k) {
    const int c = 255 - (int)(LC[k] & 255u), i = c >> 4, j = c & 15;
    const int i1 = 127 - (int)(la[i * 512 + tid] & 127u), i2 = 127 - (int)(lb[j * 512 + tid] & 127u);
    idxo[token * 128 + head * 16 + k] = i1 * 128 + i2;
    go[token * 128 + head * 16 + k] = ev[k] * inv;
  }
}
DEV float sw32sum(float a, float b) { auto r = __builtin_amdgcn_permlane32_swap(__float_as_uint(a), __float_as_uint(b), false, false); return __uint_as_float(r[0]) + __uint_as_float(r[1]); }
DEV float sw16sum(float a, float b) { auto r = __builtin_amdgcn_permlane16_swap(__float_as_uint(a), __float_as_uint(b), false, false); return __uint_as_float(r[0]) + __uint_as_float(r[1]); }
template <int N> DEV float row_ror_add(float v) { return v + __uint_as_float((unsigned)__builtin_amdgcn_update_dpp(0, (int)__float_as_uint(v), 0x120 + N, 0xf, 0xf, false)); }
DEV float row_allsum(float v) { v = row_ror_add<8>(v); v = row_ror_add<4>(v); v = row_ror_add<2>(v); v = row_ror_add<1>(v); return v; }
DEV f32x2_t fp8x2(unsigned d, bool hiw) { return hiw ? __builtin_amdgcn_cvt_pk_f32_fp8((int)d, true) : __builtin_amdgcn_cvt_pk_f32_fp8((int)d, false); }
constexpr float TAB_SCALE = 64.f, TAB_INV = 1.f / 64.f;
DEV void peer_gather(const Params& P, int l, int m0, const int* idxs, const float* gs) {
  const int tid = tid_l(), lane = tid & 63, wid = tid >> 6;
  const unsigned char* U = P.ws + WS_TAB + (size_t)l * 32 * MB;
  const unsigned char* V = U + 16 * MB;
  bf16_t* hn = (bf16_t*)(P.ws + WS_HN);
  const float* gp = P.norm_ple + l * DM;
  const int row = lane >> 4, rmap = ((row & 1) << 1) | (row >> 1);
#pragma nounroll
  for (int i = 0; i < 16; ++i) {
    const int tt = wid * 16 + i; const size_t tok = (size_t)(m0 + tt);
    __syncthreads();
    const u32x4 xa = *(const u32x4*)(hn + tok * DM + lane * 16), xb = *(const u32x4*)(hn + tok * DM + lane * 16 + 8);
    f32x2_t xp[8];
#pragma unroll
    for (int q = 0; q < 4; ++q) { xp[q] = (f32x2_t){bflo(xa[q]), bfhi(xa[q])}; xp[4 + q] = (f32x2_t){bflo(xb[q]), bfhi(xb[q])}; }
    int myi0 = idxs[tt * 128 + lane], myi1 = idxs[tt * 128 + 64 + lane];
    float myg0 = gs[tt * 128 + lane], myg1 = gs[tt * 128 + 64 + lane];
#pragma unroll
    for (int k = 2; k <= 128; k <<= 1) {
#pragma unroll
      for (int j = k >> 1; j >= 1; j >>= 1) {
        if (j == 64) {
          const bool sw_ = myi1 < myi0;
          const int ti = sw_ ? myi1 : myi0, tj = sw_ ? myi0 : myi1; const float tg = sw_ ? myg1 : myg0, th = sw_ ? myg0 : myg1;
          myi0 = ti; myi1 = tj; myg0 = tg; myg1 = th;
        } else {
          const bool lower = (lane & j) == 0;
          {
            const bool up = (k == 128) ? true : ((k == 64) ? true : ((lane & k) == 0));
            const int oi = __shfl_xor(myi0, j); const float og = __shfl_xor(myg0, j);
            const bool take = (lower == up) ? (oi < myi0) : (oi > myi0);
            myi0 = take ? oi : myi0; myg0 = take ? og : myg0;
          }
          {
            const bool up = (k == 128) ? true : ((k == 64) ? false : ((lane & k) == 0));
            const int oi = __shfl_xor(myi1, j); const float og = __shfl_xor(myg1, j);
            const bool take = (lower == up) ? (oi < myi1) : (oi > myi1);
            myi1 = take ? oi : myi1; myg1 = take ? og : myg1;
          }
        }
      }
    }
    f32x2_t acc[8];
#pragma unroll
    for (int q = 0; q < 8; ++q) acc[q] = (f32x2_t){0.f, 0.f};
    float wr0 = 0.f, wr1 = 0.f;
    u32x4 b0[16], b1[16];
#define PG_ISSUE(BUF, TAB, e0_) do { const int isrc_ = ((e0_) < 64) ? myi0 : myi1; \
      _Pragma("unroll") for (int e = 0; e < 16; ++e) { const int idx_ = __builtin_amdgcn_readlane(isrc_, ((e0_) + e) & 63); \
        BUF[e] = *(const u32x4*)((TAB) + (size_t)idx_ * 1024 + lane * 16); } } while (0)
#define PG_U8(BUF, o_, e0_) do { float d_[8]; \
      _Pragma("unroll") for (int e = 0; e < 8; ++e) { f32x2_t s_ = {0.f, 0.f}; \
        _Pragma("unroll") for (int q = 0; q < 4; ++q) { s_ = __builtin_elementwise_fma(xp[2 * q], fp8x2(BUF[(o_) + e][q], false), s_); s_ = __builtin_elementwise_fma(xp[2 * q + 1], fp8x2(BUF[(o_) + e][q], true), s_); } \
        d_[e] = s_[0] + s_[1]; } \
      float s0_ = sw16sum(sw32sum(d_[0], d_[1]), sw32sum(d_[2], d_[3])); \
      float s1_ = sw16sum(sw32sum(d_[4], d_[5]), sw32sum(d_[6], d_[7])); \
      s0_ = row_allsum(s0_) * TAB_INV; s1_ = row_allsum(s1_) * TAB_INV; \
      const float gsrc_ = ((e0_) < 64) ? myg0 : myg1; \
      const float w0_ = __shfl(gsrc_, ((e0_) + (o_) + rmap) & 63) * gelu_tanh(s0_), w1_ = __shfl(gsrc_, ((e0_) + (o_) + 4 + rmap) & 63) * gelu_tanh(s1_); \
      _Pragma("unroll") for (int e = 0; e < 8; ++e) { const int rw_ = (((e & 1) << 1) | ((e >> 1) & 1)) * 16; \
        const float we_ = __uint_as_float(__builtin_amdgcn_readlane(__float_as_uint((e < 4) ? w0_ : w1_), rw_)); \
        if ((e0_) < 64) wr0 = (lane == (((e0_) + (o_) + e) & 63)) ? we_ : wr0; else wr1 = (lane == (((e0_) + (o_) + e) & 63)) ? we_ : wr1; } } while (0)
#define PG_V16(BUF, e0_) do { const float wsrc_ = ((e0_) < 64) ? wr0 : wr1; \
      _Pragma("unroll") for (int e = 0; e < 16; ++e) { \
        const float we_ = __uint_as_float(__builtin_amdgcn_readlane(__float_as_uint(wsrc_), ((e0_) + e) & 63)); const f32x2_t w2_ = {we_, we_}; \
        _Pragma("unroll") for (int q = 0; q < 4; ++q) { acc[2 * q] = __builtin_elementwise_fma(w2_, fp8x2(BUF[e][q], false), acc[2 * q]); acc[2 * q + 1] = __builtin_elementwise_fma(w2_, fp8x2(BUF[e][q], true), acc[2 * q + 1]); } } } while (0)
    PG_ISSUE(b0, U, 0);
#pragma nounroll
    for (int e0 = 0; e0 < 128; e0 += 32) {
      PG_ISSUE(b1, U, e0 + 16);
      PG_U8(b0, 0, e0); PG_U8(b0, 8, e0);
      if (e0 + 32 < 128) PG_ISSUE(b0, U, e0 + 32); else PG_ISSUE(b0, V, 0);
      PG_U8(b1, 0, e0 + 16); PG_U8(b1, 8, e0 + 16);
    }
#pragma nounroll
    for (int e0 = 0; e0 < 128; e0 += 32) {
      PG_ISSUE(b1, V, e0 + 16);
      PG_V16(b0, e0);
      if (e0 + 32 < 128) PG_ISSUE(b0, V, e0 + 32);
      PG_V16(b1, e0 + 16);
    }
#undef PG_ISSUE
#undef PG_U8
#undef PG_V16
    float* hrow = P.out + tok * DM + lane * 16;
    f32x4 hv[4]; float ss = 0.f;
#pragma unroll
    for (int q = 0; q < 4; ++q) hv[q] = *(const f32x4*)(hrow + 4 * q);
#pragma unroll
    for (int q = 0; q < 4; ++q) {
      hv[q][0] += acc[2 * q][0] * TAB_INV; hv[q][1] += acc[2 * q][1] * TAB_INV; hv[q][2] += acc[2 * q + 1][0] * TAB_INV; hv[q][3] += acc[2 * q + 1][1] * TAB_INV;
      ss += hv[q][0] * hv[q][0] + hv[q][1] * hv[q][1] + hv[q][2] * hv[q][2] + hv[q][3] * hv[q][3];
      *(f32x4*)(hrow + 4 * q) = hv[q];
    }
    const float rstd = rsqrtf(wave_sum(ss) * (1.f / DM) + EPS);
    u32x4 oa, ob;
#pragma unroll
    for (int q = 0; q < 4; ++q) {
      const f32x4 g = *(const f32x4*)(gp + lane * 16 + 4 * q);
      const unsigned p0 = pk2(hv[q][0] * rstd * g[0], hv[q][1] * rstd * g[1]), p1 = pk2(hv[q][2] * rstd * g[2], hv[q][3] * rstd * g[3]);
      if (q < 2) { oa[2 * q] = p0; oa[2 * q + 1] = p1; } else { ob[2 * (q - 2)] = p0; ob[2 * (q - 2) + 1] = p1; }
    }
    *(u32x4*)(hn + tok * DM + lane * 16) = oa; *(u32x4*)(hn + tok * DM + lane * 16 + 8) = ob;
  }
}
DEV void resid_gemm(const Params& P, int m0, const bf16_t* A, const bf16_t* Wt, const float* base) {
  gemm_seq<22, 22>(4, [&](int nt) { return GTile{A + (size_t)m0 * DM, DM, Wt + (size_t)nt * 256 * DM, DM, DM}; },
                   [&](int nt, f32x16 (&acc)[2][2], int stg) { epi_resid_f32(acc, base, P.out, m0, nt * 256, stg); });
}
DEV void chain_peer_ple(const Params& P, int l, int p) {
  GEO
  const int m0 = p * 128;
  bf16_t* hn = (bf16_t*)(P.ws + WS_HN);
  unsigned char* slice = P.ws + WS_Z + (size_t)p * SLICE;
  float* scoresT = (float*)slice; int* idxs = (int*)(slice + 512 * 1024); float* gs = (float*)(slice + 576 * 1024);
  __syncthreads();
  panel_rmsnorm(P.out, P.norm_ffn + l * DM, hn, m0);
  const bf16_t* wpt = (const bf16_t*)(P.ws + W_PT) + (size_t)l * 2048 * 1024;
#pragma nounroll
  for (int hg = 0; hg < 2; ++hg) {
    gemm_seq<63, 63>(4, [&](int nt) { return GTile{hn + (size_t)m0 * DM, DM, wpt + (size_t)((hg * 4 + nt) * 256) * DM, DM, DM}; }, [&](int nt, f32x16 (&acc)[2][2], int) {
      FOR_ACC {
        const int tr = 64 * wm + 32 * mb + l32, col = nt * 256 + 64 * wn + 32 * nb + 8 * rq + 4 * hi;
#pragma unroll
        for (int e = 0; e < 4; ++e) scoresT[(size_t)(col + e) * 128 + tr] = acc[nb][mb][4 * rq + e];
      }
    });
    __syncthreads();
    if (l == 0 && hg == 0) STAMP(16);
    topk_group(hg, scoresT, idxs, gs);
    __syncthreads();
    if (l == 0 && hg == 0) STAMP(17);
  }
  if (l == 0) STAMP(12);
  peer_gather(P, l, m0, idxs, gs);
  __syncthreads();
  if (l == 0) STAMP(13);
  const bf16_t* wg = (const bf16_t*)(P.ws + W_GATE) + (size_t)l * 1024 * 1024;
  const bf16_t* wu = (const bf16_t*)(P.ws + W_UP) + (size_t)l * 1024 * 256;
  const bf16_t* pb = (const bf16_t*)(P.ws + WS_PB) + ((size_t)l * T_TOK + m0) * 256;
  {
    unsigned sg[2][2][8];
    gemm_seq<22, 6>(8, [&](int i) { const int nt = i >> 1;
        return (i & 1) ? GTile{pb, 256, wu + (size_t)nt * 256 * 256, 256, 256} : GTile{hn + (size_t)m0 * DM, DM, wg + (size_t)nt * 256 * DM, DM, DM}; },
      [&](int i, f32x16 (&acc)[2][2], int stg) {
        if (!(i & 1)) {
#pragma unroll
          for (int nb = 0; nb < 2; ++nb)
#pragma unroll
            for (int mb = 0; mb < 2; ++mb)
#pragma unroll
              for (int q = 0; q < 8; ++q) sg[nb][mb][q] = pk2(sigmoidf_(acc[nb][mb][2 * q]), sigmoidf_(acc[nb][mb][2 * q + 1]));
        } else {
#pragma unroll
          for (int nb = 0; nb < 2; ++nb)
#pragma unroll
            for (int mb = 0; mb < 2; ++mb)
#pragma unroll
              for (int q = 0; q < 8; ++q) { acc[nb][mb][2 * q] *= bflo(sg[nb][mb][q]); acc[nb][mb][2 * q + 1] *= bfhi(sg[nb][mb][q]); }
          epi_resid_f32(acc, P.out, P.out, m0, (i >> 1) * 256, stg);
        }
      });
  }
  __syncthreads();
}

DEV void l1_inproj(const Params& P, int p) {
  GEO
  const int m0 = p * 128;
  bf16_t* hn = (bf16_t*)(P.ws + WS_HN);
  bf16_t* zz = (bf16_t*)(P.ws + WS_Z + (size_t)p * SLICE);
  panel_rmsnorm(P.out, P.norm_mix + DM, hn, m0);
  const bf16_t* wt = (const bf16_t*)(P.ws + W_IN1);
  gemm_seq<14, 14>(8, [&](int nt) { return GTile{hn + (size_t)m0 * DM, DM, wt + (size_t)nt * 256 * DM, DM, DM}; },
                   [&](int nt, f32x16 (&acc)[2][2], int stg) { epi_rows_bf16(acc, stg, [&](int tr, int cr, u32x4 v) { *(u32x4*)(zz + (size_t)tr * 2048 + nt * 256 + cr) = v; }); });
}
DEV void p4_panel(const Params& P, int p) {
  GEO
  const int m0 = p * 128, s0 = m0 % SEQ;
  bf16_t* xrc = (bf16_t*)(P.ws + WS_HN);
  const bf16_t* zz = (const bf16_t*)(P.ws + WS_Z + (size_t)p * SLICE);
  const bf16_t* zzp = (const bf16_t*)(P.ws + WS_Z + (size_t)(p - 1) * SLICE);
  bf16_t* la = (bf16_t*)(P.ws + WS_TAB + 64 * MB);
  bf16_t* ub = (bf16_t*)(P.ws + WS_Z + (size_t)p * SLICE + 512 * 1024);
  __syncthreads();
  {
    const int ch = 2 * tid;
    const float w0a = P.odd_conv_w[ch], w0b = P.odd_conv_w[ch + 1], w1a = P.odd_conv_w[1024 + ch], w1b = P.odd_conv_w[1025 + ch];
    const float w2a = P.odd_conv_w[2048 + ch], w2b = P.odd_conv_w[2049 + ch], w3a = P.odd_conv_w[3072 + ch], w3b = P.odd_conv_w[3073 + ch];
    const float cba = P.odd_conv_b[ch], cbb = P.odd_conv_b[ch + 1];
    float x3a = 0.f, x3b = 0.f, x2a = 0.f, x2b = 0.f, x1a = 0.f, x1b = 0.f;
    if (s0 > 0) {
      const unsigned h3 = *(const unsigned*)(zzp + (size_t)125 * 2048 + 1024 + ch), h2 = *(const unsigned*)(zzp + (size_t)126 * 2048 + 1024 + ch), h1 = *(const unsigned*)(zzp + (size_t)127 * 2048 + 1024 + ch);
      x3a = bflo(h3); x3b = bfhi(h3); x2a = bflo(h2); x2b = bfhi(h2); x1a = bflo(h1); x1b = bfhi(h1);
    }
#pragma nounroll
    for (int tb = 0; tb < 128; tb += 32) {
      unsigned xv[32];
#pragma unroll
      for (int i = 0; i < 32; ++i) xv[i] = *(const unsigned*)(zz + (size_t)(tb + i) * 2048 + 1024 + ch);
#pragma unroll
      for (int i = 0; i < 32; ++i) {
        const float x0a = bflo(xv[i]), x0b = bfhi(xv[i]);
        *(unsigned*)(xrc + (size_t)(m0 + tb + i) * DM + ch) = pk2(w0a * x3a + w1a * x2a + w2a * x1a + w3a * x0a + cba, w0b * x3b + w1b * x2b + w2b * x1b + w3b * x0b + cbb);
        x3a = x2a; x2a = x1a; x1a = x0a; x3b = x2b; x2b = x1b; x1b = x0b;
      }
    }
  }
  __syncthreads();
  const bf16_t* wax = (const bf16_t*)(P.ws + W_AX);
  gemm_seq<22, 22>(8, [&](int h) { return GTile{xrc + (size_t)m0 * DM + h * 128, DM, wax + (size_t)h * 256 * 128, 128, 128}; }, [&](int h, f32x16 (&acc)[2][2], int) {
    u32x2 xrl[4][2];
#pragma unroll
    for (int rq = 0; rq < 4; ++rq)
#pragma unroll
      for (int mb = 0; mb < 2; ++mb) xrl[rq][mb] = *(const u32x2*)(xrc + (size_t)(m0 + 64 * wm + 32 * mb + l32) * DM + h * 128 + 32 * wn + 8 * rq + 4 * hi);
#pragma unroll
    for (int rq = 0; rq < 4; ++rq) {
      const int ch = h * 128 + 32 * wn + 8 * rq + 4 * hi;
      const f32x4 ba = *(const f32x4*)(P.odd_b_a + ch), bx = *(const f32x4*)(P.odd_b_x + ch), sp = *(const f32x4*)((const float*)(P.ws + WS_PTOT + 196608) + ch);
#pragma unroll
      for (int mb = 0; mb < 2; ++mb) {
        const int tr = 64 * wm + 32 * mb + l32; const size_t tok = (size_t)(m0 + tr);
        const u32x2 xr = xrl[rq][mb];
        const float xv[4] = {bflo(xr[0]), bfhi(xr[0]), bflo(xr[1]), bfhi(xr[1])};
        float lav[4], uv[4];
#pragma unroll
        for (int e = 0; e < 4; ++e) {
          const float rg = sigmoidf_(acc[0][mb][4 * rq + e] + ba[e]), ig = sigmoidf_(acc[1][mb][4 * rq + e] + bx[e]);
          lav[e] = -8.f * rg * sp[e];
          uv[e] = __builtin_amdgcn_sqrtf(neg_expm1(2.f * lav[e])) * (ig * xv[e]);
        }
        u32x2 o1, o2; o1[0] = pk2(lav[0], lav[1]); o1[1] = pk2(lav[2], lav[3]); o2[0] = pk2(uv[0], uv[1]); o2[1] = pk2(uv[2], uv[3]);
        *(u32x2*)(la + tok * DM + ch) = o1;
        *(u32x2*)(ub + (size_t)tr * DM + ch) = o2;
      }
    }
  });
  __syncthreads();
  float* aprod = (float*)(P.ws + WS_APROD); float* hend = (float*)(P.ws + WS_HEND);
  {
    const int ch = 2 * tid;
    float Asa = 0.f, Asb = 0.f, Ha = 0.f, Hb = 0.f;
#pragma nounroll
    for (int tb = 0; tb < 128; tb += 32) {
      unsigned lv[32], uv[32];
#pragma unroll
      for (int i = 0; i < 32; ++i) { lv[i] = *(const unsigned*)(la + (size_t)(m0 + tb + i) * DM + ch); uv[i] = *(const unsigned*)(ub + (size_t)(tb + i) * DM + ch); }
#pragma unroll
      for (int i = 0; i < 32; ++i) {
        const float la_a = bflo(lv[i]), la_b = bfhi(lv[i]);
        Ha = __expf(la_a) * Ha + bflo(uv[i]); Hb = __expf(la_b) * Hb + bfhi(uv[i]); Asa += la_a; Asb += la_b;
      }
    }
    f32x2_t ao = {__expf(Asa), __expf(Asb)}, ho = {Ha, Hb};
    *(f32x2_t*)(aprod + p * DM + ch) = ao; *(f32x2_t*)(hend + p * DM + ch) = ho;
  }
}
DEV void p5_pre(const Params& P, int p) {
  GEO
  const int m0 = p * 128;
  const int pfirst = (p >> 7) << 7;
  const float* aprod = (const float*)(P.ws + WS_APROD); const float* hend = (const float*)(P.ws + WS_HEND);
  const bf16_t* la = (const bf16_t*)(P.ws + WS_TAB + 64 * MB);
  const bf16_t* ub = (const bf16_t*)(P.ws + WS_Z + (size_t)p * SLICE + 512 * 1024);
  const bf16_t* zz = (const bf16_t*)(P.ws + WS_Z + (size_t)p * SLICE);
  bf16_t* y = (bf16_t*)(P.ws + WS_HN);
  __syncthreads();
  {
    const int ch = 2 * tid;
    float Ha = 0.f, Hb = 0.f;
#pragma unroll 8
    for (int pp = pfirst; pp < p; ++pp) {
      const f32x2_t a2 = *(const f32x2_t*)(aprod + pp * DM + ch), h2 = *(const f32x2_t*)(hend + pp * DM + ch);
      Ha = a2[0] * Ha + h2[0]; Hb = a2[1] * Hb + h2[1];
    }
#pragma nounroll
    for (int tb = 0; tb < 128; tb += 32) {
      unsigned lv[32], uv[32], gv[32];
#pragma unroll
      for (int i = 0; i < 32; ++i) { lv[i] = *(const unsigned*)(la + (size_t)(m0 + tb + i) * DM + ch); uv[i] = *(const unsigned*)(ub + (size_t)(tb + i) * DM + ch); gv[i] = *(const unsigned*)(zz + (size_t)(tb + i) * 2048 + ch); }
#pragma unroll
      for (int i = 0; i < 32; ++i) {
        Ha = __expf(bflo(lv[i])) * Ha + bflo(uv[i]); Hb = __expf(bfhi(lv[i])) * Hb + bfhi(uv[i]);
        *(unsigned*)(y + (size_t)(m0 + tb + i) * DM + ch) = pk2(Ha * gelu_tanh(bflo(gv[i])), Hb * gelu_tanh(bfhi(gv[i])));
      }
    }
  }
  __syncthreads();
}


#define XB_TMO      128
#define XB_XCNT(j)  (256  + 64 * (j))
#define XB_XSUB(j)  (1280 + 64 * (j))
#define XB_XGEN(j)  (2304 + 64 * (j))
#define XB_TOP      3328
#define XB_TOPGEN   3392
#define XCD_BAR_WORDS 3456
#define XB_SPIN_CAP (1u << 18)
#define LAS3 __attribute__((address_space(3)))
DEV unsigned xb_ld(unsigned* p) { return __hip_atomic_load(p, __ATOMIC_RELAXED, __HIP_MEMORY_SCOPE_AGENT); }
DEV unsigned xb_add(unsigned* p, unsigned v) { return __hip_atomic_fetch_add(p, v, __ATOMIC_RELAXED, __HIP_MEMORY_SCOPE_AGENT); }
DEV unsigned xb_xcc_id() { return (unsigned)__builtin_amdgcn_s_getreg((3 << 11) | 20) & 0xFu; }
#define XB_SPIN(cond, bar) do { unsigned _sp = 0; while (cond) { __builtin_amdgcn_s_sleep(1); \
    if ((++_sp & 255u) == 0u) { if (xb_ld(&(bar)[XB_TMO])) break; if (_sp > XB_SPIN_CAP) { atomicAdd(&(bar)[XB_TMO], 1u); break; } } } } while (0)
struct XcdBarrier { unsigned* bar; unsigned x; volatile LAS3 unsigned* st; };
DEV XcdBarrier xcd_barrier_post(unsigned* bar, volatile LAS3 unsigned* st) {
  XcdBarrier b; b.bar = bar; b.x = xb_xcc_id(); b.st = st;
  if (threadIdx.x == 0) (void)xb_add(&bar[XB_XCNT(b.x)], 1u);
  return b;
}
DEV void xcd_barrier_complete(unsigned* bar, unsigned x, unsigned& nloc, unsigned& nx) {
  const unsigned G = gridDim.x * gridDim.y * gridDim.z;
  unsigned sum, cnt, mine, sp = 0u;
  for (;;) {
    sum = 0u; cnt = 0u; mine = 0u;
#pragma unroll
    for (unsigned j = 0; j < 16; ++j) { const unsigned c = xb_ld(&bar[XB_XCNT(j)]); sum += c; cnt += (c > 0u) ? 1u : 0u; mine = (j == x) ? c : mine; }
    if (sum == G) break;
    __builtin_amdgcn_s_sleep(1);
    if ((++sp & 255u) == 0u) { if (xb_ld(&bar[XB_TMO])) break; if (sp > XB_SPIN_CAP) { atomicAdd(&bar[XB_TMO], 1u); break; } }
  }
  nloc = mine > 0u ? mine : 1u; nx = cnt > 0u ? cnt : 1u;
}
DEV void xcd_barrier(const XcdBarrier& b) {
  asm volatile("s_waitcnt vmcnt(0)" ::: "memory");
  __syncthreads();
  if (threadIdx.x == 0) {
    unsigned* bar = b.bar;
    __builtin_amdgcn_s_waitcnt(0);
    unsigned nloc = b.st[0], nx = b.st[1];
    if (nloc == 0u) { xcd_barrier_complete(bar, b.x, nloc, nx); b.st[0] = nloc; b.st[1] = nx; }
    const unsigned old = xb_add(&bar[XB_XSUB(b.x)], 1u);
    const unsigned gen = old / nloc;
    if (old + 1u == (gen + 1u) * nloc) {
      __builtin_amdgcn_fence(__ATOMIC_RELEASE, "agent");
      asm volatile("s_waitcnt vmcnt(0)" ::: "memory");
      const unsigned og = xb_add(&bar[XB_TOP], 1u);
      const unsigned tg = og / nx;
      if (og + 1u == (tg + 1u) * nx) xb_add(&bar[XB_TOPGEN], 1u);
      else XB_SPIN(xb_ld(&bar[XB_TOPGEN]) == tg, bar);
      __builtin_amdgcn_fence(__ATOMIC_ACQUIRE, "agent");
      xb_add(&bar[XB_XGEN(b.x)], 1u);
      asm volatile("s_waitcnt vmcnt(0)" ::: "memory");
    } else {
      XB_SPIN(xb_ld(&bar[XB_XGEN(b.x)]) == gen, bar);
      __builtin_amdgcn_fence(__ATOMIC_ACQUIRE, "agent");
      asm volatile("s_waitcnt vmcnt(0)" ::: "memory");
    }
  }
  __syncthreads();
}
__global__ void __launch_bounds__(512) mega(Params P) {
  cg::grid_group grid = cg::this_grid();
  const int tid = threadIdx.x;
  unsigned char* ws = P.ws;
  volatile LAS3 unsigned* xst = (volatile LAS3 unsigned*)(smem + LDS_BYTES - 64);
  if (tid == 0) { xst[0] = 0u; xst[1] = 0u; xst[2] = 0u; xst[3] = 0u; }
  __syncthreads();
  const XcdBarrier xbar = xcd_barrier_post((unsigned*)(ws + WS_PTOT + 131072), xst);
  STAMP(0);
  if (blockIdx.x == 0 && tid == 0) { *(unsigned*)(ws + WS_PTOT + 65536) = 0u; *(unsigned*)(ws + WS_PTOT + 65536 + 64) = 0u; }
  transpose_job(P.even_w_in, 1024, 3072, 3080, (bf16_t*)(ws + W_IN0), 1024);
  transpose_job(P.even_w_out, 1024, 1024, 1024, (bf16_t*)(ws + W_OUT0), 1024);
  transpose_job(P.odd_w_in, 1024, 2048, 2048, (bf16_t*)(ws + W_IN1), 1024);
  transpose_job(P.odd_w_out, 1024, 1024, 1024, (bf16_t*)(ws + W_OUT1), 1024);
#pragma nounroll
  for (int l = 0; l < 2; ++l) {
    transpose_job(P.ple_up + (size_t)l * 256 * 1024, 256, 1024, 1024, (bf16_t*)(ws + W_UP) + (size_t)l * 1024 * 256, 256);
    transpose_job(P.ple_gate + (size_t)l * 1024 * 1024, 1024, 1024, 1024, (bf16_t*)(ws + W_GATE) + (size_t)l * 1024 * 1024, 1024);
  }
  convert_job(P.peer_wq, (bf16_t*)(ws + W_QB), (size_t)2 * 1024 * 2048);
  {
    const int gsz = gridDim.x * 512, gid = blockIdx.x * 512 + tid;
    bf16_t* bsk = (bf16_t*)(ws + W_SK);
    for (int i = gid; i < 2 * 65536; i += gsz) {
      const int l = i >> 16, n = (i >> 8) & 255, k = i & 255;
      float v = 0.f;
      if ((n < 128) == (k < 128)) v = P.peer_sk[(size_t)l * 32768 + (size_t)(n >> 7) * 16384 + (n & 127) * 128 + (k & 127)];
      bsk[i] = f2bf(v);
    }
    float* spt = (float*)(ws + WS_PTOT + 196608);
    for (int i = gid; i < 1024; i += gsz) { const float nl = -P.odd_lru[i]; spt[i] = fmaxf(nl, 0.f) + log1pf(__expf(-fabsf(nl))); }
    bf16_t* wax = (bf16_t*)(ws + W_AX);
    for (int i = gid; i < 8 * 256 * 128; i += gsz) {
      const int h = i >> 15, n = (i >> 7) & 255, k = i & 127;
      const int wn = n >> 6, nb = (n >> 5) & 1, jj = n & 31;
      const float* src = nb ? P.odd_w_x : P.odd_w_a;
      wax[i] = f2bf(src[(size_t)h * 16384 + k * 128 + 32 * wn + jj]);
    }
  }
  grid.sync(); STAMP(1);
#pragma nounroll
  for (int p = blockIdx.x; p < NPANEL; p += gridDim.x) { asm volatile("" ::: "memory"); p1_panel(P, p); }
#pragma nounroll
  for (int u = blockIdx.x; u < 128; u += gridDim.x) { asm volatile("" ::: "memory"); fold_unit(P, u); }
  xcd_barrier(xbar); STAMP(2);
  {
    int* hs = (int*)(smem + AT_SUF + 1024 + 64);
    unsigned* ctr = (unsigned*)(ws + WS_PTOT + 65536);
    if (tid < 8) {
      const float mine = P.even_b_forget[tid]; int rank = 0;
      for (int j = 0; j < 8; ++j) { const float o = P.even_b_forget[j]; rank += (o < mine || (o == mine && j < tid)) ? 1 : 0; }
      hs[rank] = tid;
    }
    {
      const float* ptot = (const float*)(ws + WS_PTOT);
      float* offt = (float*)(smem + AT_OFF);
      const int seq = tid >> 5, l5 = tid & 31, bb = seq >> 3, hh_ = seq & 7;
      float v0 = ptot[(bb * 128 + 4 * l5 + 0) * 8 + hh_], v1 = ptot[(bb * 128 + 4 * l5 + 1) * 8 + hh_], v2 = ptot[(bb * 128 + 4 * l5 + 2) * 8 + hh_], v3 = ptot[(bb * 128 + 4 * l5 + 3) * 8 + hh_];
      const float tot = (v0 + v1) + (v2 + v3);
      float inc = tot;
#pragma unroll
      for (int o_ = 1; o_ < 32; o_ <<= 1) { const float nb_ = __shfl_up(inc, o_, 32); if (l5 >= o_) inc += nb_; }
      const float ex = inc - tot;
      offt[seq * 128 + 4 * l5 + 0] = ex; offt[seq * 128 + 4 * l5 + 1] = ex + v0; offt[seq * 128 + 4 * l5 + 2] = ex + v0 + v1; offt[seq * 128 + 4 * l5 + 3] = ex + v0 + v1 + v2;
    }
#pragma nounroll
    for (;;) {
      __syncthreads();
      if (tid == 0) hs[8] = (int)atomicAdd(ctr, 1u);
      __syncthreads();
      const int u = hs[8];
      if (u >= 2048) break;
      const int qb = 127 - (u >> 4), bh = u & 15, b = bh >> 3;
      const int hh = hs[7 - (bh & 7)];
      asm volatile("" ::: "memory");
      attn_unit(P, b, qb, hh);
    }
    unsigned* ctr2 = ctr + 16;
#pragma nounroll
    for (;;) {
      __syncthreads();
      if (tid == 0) hs[8] = (int)atomicAdd(ctr2, 1u);
      __syncthreads();
      const int c = hs[8];
      if (c >= 2560) break;
      if (c < 2048) {
        const int t = c >> 9; const size_t off = (size_t)(c & 511) * 32768;
        const float* src = ((t & 1) ? P.peer_v : P.peer_u) + (size_t)(t >> 1) * 16384 * 1024 + off;
        unsigned char* dst = ws + WS_TAB + (size_t)t * 16 * MB + off;
#pragma unroll
        for (int it = 0; it < 4; ++it) {
          const size_t i = (size_t)(it * 512 + tid) * 16;
          u32x4 o;
#pragma unroll
          for (int q = 0; q < 4; ++q) {
            const f32x4 a = *(const f32x4*)(src + i + 4 * q);
            int d = __builtin_amdgcn_cvt_pk_fp8_f32(a[0] * 64.f, a[1] * 64.f, 0, false);
            d = __builtin_amdgcn_cvt_pk_fp8_f32(a[2] * 64.f, a[3] * 64.f, d, true);
            o[q] = (unsigned)d;
          }
          *(u32x4*)(dst + i) = o;
        }
      } else {
        const size_t off = (size_t)(c - 2048) * 32768;
        const float* src = P.p + off; bf16_t* dst = (bf16_t*)(ws + WS_PB) + off;
#pragma unroll
        for (int it = 0; it < 8; ++it) {
          const size_t i = (size_t)(it * 512 + tid) * 8;
          const f32x4 a = *(const f32x4*)(src + i), b2 = *(const f32x4*)(src + i + 4);
          u32x4 o; o[0] = pk2(a[0], a[1]); o[1] = pk2(a[2], a[3]); o[2] = pk2(b2[0], b2[1]); o[3] = pk2(b2[2], b2[3]);
          *(u32x4*)(dst + i) = o;
        }
      }
    }
  }
#pragma nounroll
  for (int p = blockIdx.x; p < NPANEL; p += gridDim.x) { asm volatile("" ::: "memory"); conv_mixer(P, p); }
  xcd_barrier(xbar); STAMP(3);
#pragma nounroll
  for (int p = blockIdx.x; p < NPANEL; p += gridDim.x) {
    Params Q = P; asm volatile("" : "+s"(Q.ws), "+s"(Q.out) :: "memory");
    resid_gemm(Q, p * 128, (const bf16_t*)(Q.ws + WS_HN), (const bf16_t*)(Q.ws + W_OUT0), Q.x);
    STAMP(10);
    chain_peer_ple(Q, 0, p);
    STAMP(14);
    l1_inproj(Q, p);
    STAMP(15);
  }
  xcd_barrier(xbar); STAMP(4);
#pragma nounroll
  for (int p = blockIdx.x; p < NPANEL; p += gridDim.x) { asm volatile("" ::: "memory"); p4_panel(P, p); }
  xcd_barrier(xbar); STAMP(5);
#pragma nounroll
  for (int p = blockIdx.x; p < NPANEL; p += gridDim.x) {
    Params Q = P; asm volatile("" : "+s"(Q.ws), "+s"(Q.out) :: "memory");
    p5_pre(Q, p);
    STAMP(18);
    resid_gemm(Q, p * 128, (const bf16_t*)(Q.ws + WS_HN), (const bf16_t*)(Q.ws + W_OUT1), Q.out);
    chain_peer_ple(Q, 1, p);
  }
#ifdef PROBE_TS
  STAMP(6);
  if (blockIdx.x == 0 && tid == 0) {
    const unsigned long long d = (g_ts[PROBE_A1] - g_ts[PROBE_A0]) * PROBE_MULT;
    const unsigned long long t0 = __builtin_amdgcn_s_memrealtime();
    while (__builtin_amdgcn_s_memrealtime() - t0 < d) __builtin_amdgcn_s_sleep(16);
  }
#endif
}

extern "C" void kernel_launch(void* const* d_in, const int* in_sizes, int n_in, void* d_out, int out_size, void* d_ws, size_t ws_size, hipStream_t stream) {
  static int grid_blocks = 0;
  if (grid_blocks == 0) {
    if (n_in != 26 || ws_size < WS_END) { fprintf(stderr, "kernel_launch: unexpected n_in %d / ws_size %zu\n", n_in, ws_size); grid_blocks = -1; return; }
    int dev = 0, cus = 0, per_cu = 0;
    (void)hipGetDevice(&dev);
    (void)hipDeviceGetAttribute(&cus, hipDeviceAttributeMultiprocessorCount, dev);
    (void)hipFuncSetAttribute((const void*)mega, hipFuncAttributeMaxDynamicSharedMemorySize, LDS_BYTES);
    (void)hipOccupancyMaxActiveBlocksPerMultiprocessor(&per_cu, (const void*)mega, 512, LDS_BYTES);
    if (per_cu < 1) { fprintf(stderr, "kernel_launch: occupancy query reports 0 blocks per CU\n"); grid_blocks = -1; return; }
    grid_blocks = cus;
    if (grid_blocks > 256) grid_blocks = 256;
  }
  if (grid_blocks < 0) return;
  (void)hipMemsetAsync((unsigned char*)d_ws + WS_PTOT + 131072, 0, 16384, stream);
  Params P{};
  const float** pp = (const float**)&P;
  for (int i = 0; i < 26; ++i) pp[i] = (const float*)d_in[i];
  P.out = (float*)d_out; P.ws = (unsigned char*)d_ws;
  void* args[] = {&P};
  hipError_t e = hipLaunchCooperativeKernel((const void*)mega, dim3(grid_blocks), dim3(512), args, LDS_BYTES, stream);
  if (e != hipSuccess) fprintf(stderr, "cooperative launch failed: %s (grid %d)\n", hipGetErrorString(e), grid_blocks);
}
```
